# Optimizing an MI355X kernel written in HIP

```python
import math
import jax, jax.numpy as jnp
from jax import lax
import numpy as np

D_MODEL = 1024
BATCH = 16
SEQ = 2048
DEPTH = 1

PLE_DIM = 256
D_MIX = D_MODEL
M_HEADS = 4
M_DV = (D_MIX // 2) // M_HEADS
M_DK = M_DV // 2
M_CHUNK = 64
CONV_K = 3
A_HEADS = 4
A_DV = (D_MIX // 2) // A_HEADS
A_DK = A_DV // 2
Q_BLOCK = 128
D_FF = 2816
EPS = 1e-6

M_QK = M_HEADS * M_DK
M_V = M_HEADS * M_DV
M_GATES = 4 * M_HEADS
A_QK = A_HEADS * 2 * A_DK
A_V = A_HEADS * A_DV
SPLITS = (M_QK, M_QK, M_V, M_V, M_GATES, A_QK, A_QK, A_V)
D_IN = sum(SPLITS)

kernel_name = "hybrid_mlstm_diffattn_macaron_encoder"


def rmsnorm(x, g):
    xf = x.astype(jnp.float32)
    y = xf * lax.rsqrt(jnp.mean(xf * xf, axis=-1, keepdims=True) + EPS) * g.astype(jnp.float32)
    return y.astype(x.dtype)


def head_rms(x):
    return x * lax.rsqrt(jnp.mean(x * x, axis=-1, keepdims=True) + EPS)


def swiglu(x, w_in, w_out):
    gu = x @ w_in
    g, u = jnp.split(gu, 2, axis=-1)
    return (jax.nn.silu(g) * u) @ w_out


def centred_dwconv(x, w):
    c = x.shape[-1]
    pad = (CONV_K - 1) // 2
    return lax.conv_general_dilated(
        x, w.astype(x.dtype)[:, None, :], window_strides=(1,), padding=((pad, pad),),
        dimension_numbers=('NWC', 'WIO', 'NWC'), feature_group_count=c)


def mlstm_chunkwise(q, k, v, log_i, f_pre):
    B, H, S, DK = q.shape
    DV = v.shape[-1]
    L = M_CHUNK
    NC = S // L
    log_f = jax.nn.log_sigmoid(f_pre)

    def chunks(t):
        return jnp.moveaxis(t.reshape((B, H, NC, L) + t.shape[3:]), 2, 0)

    xs = (chunks(q), chunks(k), chunks(v), chunks(log_i), chunks(log_f))
    tril = jnp.tril(jnp.ones((L, L), dtype=bool))

    def step(carry, inp):
        C, n, m = carry
        qc, kc, vc, li, lf = inp
        b = jnp.cumsum(lf, axis=-1)
        d = jnp.where(tril, b[..., :, None] - b[..., None, :] + li[..., None, :], -jnp.inf)
        inter = b + m[..., None]
        mj = jnp.maximum(inter, jnp.max(d, axis=-1))
        s = jnp.einsum('bhld,bhsd->bhls', qc, kc) * jnp.exp(d - mj[..., None])
        w_inter = jnp.exp(inter - mj)
        num = (w_inter[..., None] * jnp.einsum('bhld,bhdv->bhlv', qc, C)
               + jnp.einsum('bhls,bhsv->bhlv', s, vc))
        den = w_inter * jnp.einsum('bhld,bhd->bhl', qc, n) + jnp.sum(s, axis=-1)
        hc = num / jnp.maximum(jnp.abs(den), jnp.exp(-mj))[..., None]
        bl = b[..., -1]
        g = bl[..., None] - b + li
        m_new = jnp.maximum(bl + m, jnp.max(g, axis=-1))
        decay = jnp.exp(bl + m - m_new)
        wk = jnp.exp(g - m_new[..., None])
        C_new = decay[..., None, None] * C + jnp.einsum('bhsd,bhsv->bhdv', kc * wk[..., None], vc)
        n_new = decay[..., None] * n + jnp.einsum('bhs,bhsd->bhd', wk, kc)
        return (C_new, n_new, m_new), hc

    init = (jnp.zeros((B, H, DK, DV), jnp.float32),
            jnp.zeros((B, H, DK), jnp.float32),
            jnp.zeros((B, H), jnp.float32))
    _, hs = lax.scan(step, init, xs)
    return jnp.moveaxis(hs, 0, 2).reshape(B, H, S, DV)


def mlstm_group(q, k, v, o_pre, gates, conv_w, b_gate, norm_g):
    B, S, _ = q.shape
    dt = q.dtype
    qk = jax.nn.silu(centred_dwconv(jnp.concatenate([q, k], axis=-1), conv_w))
    q, k = jnp.split(qk, 2, axis=-1)
    qh = q.astype(jnp.float32).reshape(B, S, M_HEADS, M_DK).transpose(0, 2, 1, 3)
    kh = (k.astype(jnp.float32) * (M_DK ** -0.5)).reshape(B, S, M_HEADS, M_DK).transpose(0, 2, 1, 3)
    vh = v.astype(jnp.float32).reshape(B, S, M_HEADS, M_DV).transpose(0, 2, 1, 3)
    gt = (gates.astype(jnp.float32) + b_gate.astype(jnp.float32)).reshape(B, S, 4, M_HEADS)
    gt = gt.transpose(2, 0, 3, 1)
    i_fw, f_fw, i_bw, f_bw = gt[0], gt[1], gt[2], gt[3]
    h_fw = mlstm_chunkwise(qh, kh, vh, i_fw, f_fw)
    flip = lambda t: jnp.flip(t, axis=2)
    h_bw = flip(mlstm_chunkwise(flip(qh), flip(kh), flip(vh), jnp.flip(i_bw, -1), jnp.flip(f_bw, -1)))
    h = head_rms(h_fw + h_bw)
    h = h.transpose(0, 2, 1, 3).reshape(B, S, M_V) * norm_g.astype(jnp.float32)
    return (jax.nn.sigmoid(o_pre.astype(jnp.float32)) * h).astype(dt)


def diff_attn_group(q, k, v, lam_q1, lam_k1, lam_q2, lam_k2, norm_g, lam_init):
    B, S, _ = q.shape
    dt = v.dtype
    qh = q.reshape(B, S, A_HEADS, 2, A_DK).transpose(0, 2, 3, 1, 4)
    kh = k.reshape(B, S, A_HEADS, 2, A_DK).transpose(0, 2, 3, 1, 4)
    vh = v.reshape(B, S, A_HEADS, A_DV).transpose(0, 2, 1, 3)
    scale = A_DK ** -0.5
    slopes = jnp.asarray(np.array([2.0 ** (-8.0 * (h + 1) / A_HEADS) for h in range(A_HEADS)],
                                  dtype=np.float32))
    f32 = jnp.float32
    lam = (jnp.exp(jnp.sum(lam_q1.astype(f32) * lam_k1.astype(f32)))
           - jnp.exp(jnp.sum(lam_q2.astype(f32) * lam_k2.astype(f32))) + lam_init)
    NB = S // Q_BLOCK
    qb = jnp.moveaxis(qh.reshape(B, A_HEADS, 2, NB, Q_BLOCK, A_DK), 3, 0)
    kpos = jnp.arange(S, dtype=jnp.int32)
    starts = jnp.arange(NB, dtype=jnp.int32) * Q_BLOCK

    def block(args):
        qblk, start = args
        s = jnp.einsum('bhcqd,bhckd->bhcqk', qblk, kh).astype(f32) * scale
        qpos = start + jnp.arange(Q_BLOCK, dtype=jnp.int32)
        dist = jnp.abs(qpos[:, None] - kpos[None, :]).astype(f32)
        s = s - slopes[None, :, None, None, None] * dist
        pr = jax.nn.softmax(s, axis=-1)
        a = pr[:, :, 0] - lam * pr[:, :, 1]
        return jnp.einsum('bhqk,bhkd->bhqd', a.astype(dt), vh)

    o = lax.map(block, (qb, starts))
    o = jnp.moveaxis(o, 0, 2).reshape(B, A_HEADS, S, A_DV)
    o = head_rms(o.astype(f32)) * (1.0 - lam_init)
    o = o.transpose(0, 2, 1, 3).reshape(B, S, A_V) * norm_g.astype(f32)
    return o.astype(dt)


def setup_inputs(seed: int = 0) -> dict:
    key = jax.random.key(seed)
    ks = jax.random.split(key, 24)
    f32 = jnp.float32
    nrm = lambda k, shape, s: jax.random.normal(k, shape, f32) * s
    gain = lambda k, shape: 1.0 + 0.05 * jax.random.normal(k, shape, f32)
    gate_noise = 0.1 * jax.random.normal(ks[7], (DEPTH, M_GATES), f32)
    f_bias = jnp.linspace(3.0, 6.0, M_HEADS, dtype=f32)
    zero_h = jnp.zeros((M_HEADS,), f32)
    b_mgate = gate_noise + jnp.concatenate([zero_h, f_bias, zero_h, f_bias])[None, :]
    return {
        "x": jax.random.normal(ks[0], (BATCH, SEQ, D_MODEL), f32),
        "p": jax.random.normal(ks[1], (DEPTH, BATCH, SEQ, PLE_DIM), f32),
        "g_ffn1": gain(ks[2], (DEPTH, D_MODEL)),
        "w_ffn1_in": nrm(ks[3], (DEPTH, D_MODEL, 2 * D_FF), D_MODEL ** -0.5),
        "w_ffn1_out": nrm(ks[4], (DEPTH, D_FF, D_MODEL), D_FF ** -0.5),
        "g_mix": gain(ks[5], (DEPTH, D_MODEL)),
        "w_in": nrm(ks[6], (DEPTH, D_MODEL, D_IN), D_MODEL ** -0.5),
        "b_mgate": b_mgate,
        "conv_w": nrm(ks[8], (DEPTH, CONV_K, 2 * M_QK), CONV_K ** -0.5),
        "g_mnorm": gain(ks[9], (DEPTH, M_V)),
        "lam_q1": nrm(ks[10], (DEPTH, A_DK), 0.1),
        "lam_k1": nrm(ks[11], (DEPTH, A_DK), 0.1),
        "lam_q2": nrm(ks[12], (DEPTH, A_DK), 0.1),
        "lam_k2": nrm(ks[13], (DEPTH, A_DK), 0.1),
        "g_anorm": gain(ks[14], (DEPTH, A_V)),
        "w_out": nrm(ks[15], (DEPTH, D_MIX, D_MODEL), D_MIX ** -0.5),
        "g_ffn2": gain(ks[16], (DEPTH, D_MODEL)),
        "w_ffn2_in": nrm(ks[17], (DEPTH, D_MODEL, 2 * D_FF), D_MODEL ** -0.5),
        "w_ffn2_out": nrm(ks[18], (DEPTH, D_FF, D_MODEL), D_FF ** -0.5),
        "g_ple": gain(ks[19], (DEPTH, D_MODEL)),
        "w_ple_gate": nrm(ks[20], (DEPTH, D_MODEL, D_MODEL), D_MODEL ** -0.5),
        "w_ple_proj": nrm(ks[21], (DEPTH, PLE_DIM, D_MODEL), PLE_DIM ** -0.5),
        "g_final": gain(ks[22], (D_MODEL,)),
    }


def reference(x, p, g_ffn1, w_ffn1_in, w_ffn1_out, g_mix, w_in, b_mgate, conv_w, g_mnorm,
              lam_q1, lam_k1, lam_q2, lam_k2, g_anorm, w_out, g_ffn2, w_ffn2_in, w_ffn2_out,
              g_ple, w_ple_gate, w_ple_proj, g_final):
    h = x
    bounds = np.cumsum(np.array(SPLITS))[:-1].tolist()
    for i in range(DEPTH):
        lam_init = 0.8 - 0.6 * math.exp(-0.3 * i)
        h = h + 0.5 * swiglu(rmsnorm(h, g_ffn1[i]), w_ffn1_in[i], w_ffn1_out[i])
        u = rmsnorm(h, g_mix[i])
        z = u @ w_in[i]
        mq, mk, mv, mo, mg, aq, ak, av = jnp.split(z, bounds, axis=-1)
        y_m = mlstm_group(mq, mk, mv, mo, mg, conv_w[i], b_mgate[i], g_mnorm[i])
        y_a = diff_attn_group(aq, ak, av, lam_q1[i], lam_k1[i], lam_q2[i], lam_k2[i],
                              g_anorm[i], lam_init)
        h = h + jnp.concatenate([y_m, y_a], axis=-1) @ w_out[i]
        h = h + 0.5 * swiglu(rmsnorm(h, g_ffn2[i]), w_ffn2_in[i], w_ffn2_out[i])
        gate = jax.nn.sigmoid((rmsnorm(h, g_ple[i]) @ w_ple_gate[i]).astype(jnp.float32))
        h = h + (gate * (p[i] @ w_ple_proj[i]).astype(jnp.float32)).astype(h.dtype)
    return rmsnorm(h, g_final)
```

```cpp
#include <hip/hip_runtime.h>
#include <hip/hip_cooperative_groups.h>
#include <cstdio>
#include <cstdint>
namespace cg = cooperative_groups;

constexpr int BATCH = 16, SEQ = 2048, DM = 1024, MTOK = BATCH * SEQ, DFF = 2816, DIN = 3088, DINP = 3328, ZLD = 2048, PLE = 256;
constexpr float EPS = 1e-6f;
constexpr float LOG2E = 1.4426950408889634f;

namespace pg8 {
#define PG8_LAS __attribute__((address_space(3)))
typedef unsigned short bf16_t;
typedef short bf16x8 __attribute__((ext_vector_type(8)));
typedef float f32x4 __attribute__((ext_vector_type(4)));
typedef unsigned u32x4 __attribute__((ext_vector_type(4)));
typedef unsigned u32x2 __attribute__((ext_vector_type(2)));
constexpr int BM = 256, BK = 64, HALF = 128, HTB = HALF * BK * 2  , STAGE_BYTES = 8 * HTB, NXCD = 8, WGM = 8;

__host__ __device__ __forceinline__ int lds_byte(int r, int c) { const int st = (r >> 4) * 2 + (c >> 5), rr = r & 15, cc = c & 31, ob = rr * 64 + cc * 2; return st * 1024 + (ob ^ (((ob >> 9) & 1) << 5)); }
__host__ __device__ __forceinline__ void stage_rc(int b, int& R, int& C) { const int st = b / 1024, sb = b % 1024, swz = sb ^ (((sb >> 9) & 1) << 5); R = (st >> 1) * 16 + swz / 64; C = (st & 1) * 32 + (swz % 64) / 2; }
__host__ __device__ __forceinline__ int perm32(int rho) { const int n = rho >> 4, i = rho & 15; return 8 * (i >> 2) + 4 * n + (i & 3); }

struct Unit { int pm, pn; };
struct Gemm { const bf16_t* A; const bf16_t* Bt; int M, N, K; };

struct StaticOrder {
    int nM, nN, nwg, G, c;
    __host__ __device__ void init(int M, int N, int G_, int c_) { nM = M / BM; nN = N / BM; nwg = nM * nN; G = G_; c = c_; }
    __host__ __device__ bool next(int i, Unit& u) const {
        const long L = (long)i * G + c; if (L >= nwg) return false;
        int wgid = (int)L; { const int q = nwg / NXCD, r = nwg % NXCD, xcd = wgid % NXCD, off = wgid / NXCD; wgid = (xcd < r ? xcd * (q + 1) : r * (q + 1) + (xcd - r) * q) + off; }
        const int nig = WGM * nN, gid = wgid / nig, fm = gid * WGM, gsz = (nM - fm) < WGM ? (nM - fm) : WGM;
        u.pm = fm + ((wgid % nig) % gsz); u.pn = (wgid % nig) / gsz; return true;
    }
    __device__ __forceinline__ void a_ready(const Unit&) const {}
    __device__ __forceinline__ void done(const Unit&) const {}
};

typedef float f32x2_t __attribute__((ext_vector_type(2))); typedef __bf16 bf16x2_t __attribute__((ext_vector_type(2)));
__device__ __forceinline__ unsigned cvt_pk_bf16(float lo, float hi) { f32x2_t v = {lo, hi}; bf16x2_t b = __builtin_convertvector(v, bf16x2_t); return __builtin_bit_cast(unsigned, b); }
__device__ __forceinline__ float fast_rcp(float x) { return __builtin_amdgcn_rcpf(x); }
__device__ __forceinline__ float sigmoid_f(float x) { return fast_rcp(1.0f + __builtin_amdgcn_exp2f(-x * LOG2E)); }


template <int MODE> struct EpiAct {
    static constexpr bool PERM = true, AFTER_DRAIN = false;
    bf16_t* O; int ldc; const float* ssq;
    __device__ __forceinline__ void operator()(const f32x4 (&acc)[2][2][4][2], const Unit& u, int wr, int wc, int fr, int fq) const {
        const int row0 = u.pm * BM + wr * 64 + fr;
#pragma unroll
        for (int ai = 0; ai < 2; ++ai)
#pragma unroll
            for (int m = 0; m < 4; ++m) {
                const int row = row0 + ai * HALF + m * 16;
                const float rs = __builtin_amdgcn_rsqf(ssq[row] * (1.0f / DM) + EPS);
                if (MODE == 0) {
                    u32x4 w; float o[8];
#pragma unroll
                    for (int n = 0; n < 2; ++n)
#pragma unroll
                        for (int j = 0; j < 4; ++j) { const float g = acc[ai][0][m][n][j] * rs, up = acc[ai][1][m][n][j] * rs; o[n * 4 + j] = g * sigmoid_f(g) * up; }
                    w.x = cvt_pk_bf16(o[0], o[1]); w.y = cvt_pk_bf16(o[2], o[3]); w.z = cvt_pk_bf16(o[4], o[5]); w.w = cvt_pk_bf16(o[6], o[7]);
                    *(u32x4*)(O + (size_t)row * ldc + u.pn * HALF + wc * 32 + 8 * fq) = w;
                } else {
#pragma unroll
                    for (int bj = 0; bj < 2; ++bj) {
                        u32x4 w; float o[8];
#pragma unroll
                        for (int n = 0; n < 2; ++n)
#pragma unroll
                            for (int j = 0; j < 4; ++j) o[n * 4 + j] = sigmoid_f(acc[ai][bj][m][n][j] * rs);
                        w.x = cvt_pk_bf16(o[0], o[1]); w.y = cvt_pk_bf16(o[2], o[3]); w.z = cvt_pk_bf16(o[4], o[5]); w.w = cvt_pk_bf16(o[6], o[7]);
                        *(u32x4*)(O + (size_t)row * ldc + u.pn * BM + bj * HALF + wc * 32 + 8 * fq) = w;
                    }
                }
            }
    }
};

struct EpiZ {
    static constexpr bool PERM = true, AFTER_DRAIN = false;
    bf16_t* zb; bf16_t* kt; bf16_t* vt; const float* ssq;
    __device__ __forceinline__ void operator()(const f32x4 (&acc)[2][2][4][2], const Unit& u, int wr, int wc, int fr, int fq) const {
        const int row0 = u.pm * BM + wr * 64 + fr;
#pragma unroll
        for (int ai = 0; ai < 2; ++ai)
#pragma unroll
            for (int m = 0; m < 4; ++m) {
                const int row = row0 + ai * HALF + m * 16;
                const float rs = __builtin_amdgcn_rsqf(ssq[row] * (1.0f / DM) + EPS);
                if (u.pn < 10) {
                    const int b = row >> 11, s = row & (SEQ - 1);
#pragma unroll
                    for (int bj = 0; bj < 2; ++bj) {
                        u32x4 w;
                        w.x = cvt_pk_bf16(acc[ai][bj][m][0][0] * rs, acc[ai][bj][m][0][1] * rs); w.y = cvt_pk_bf16(acc[ai][bj][m][0][2] * rs, acc[ai][bj][m][0][3] * rs);
                        w.z = cvt_pk_bf16(acc[ai][bj][m][1][0] * rs, acc[ai][bj][m][1][1] * rs); w.w = cvt_pk_bf16(acc[ai][bj][m][1][2] * rs, acc[ai][bj][m][1][3] * rs);
                        if (u.pn < 8) *(u32x4*)(zb + (size_t)row * ZLD + u.pn * BM + bj * HALF + wc * 32 + 8 * fq) = w;
                        else *(u32x4*)(kt + ((size_t)((b * 4 + 2 * (u.pn - 8) + bj) * 32 + (s >> 6)) * 64 + (s & 63)) * 128 + wc * 32 + 8 * fq) = w;
                    }
                } else if (u.pn < 12) {
                    const int b = row >> 11, s = row & (SEQ - 1);
#pragma unroll
                    for (int bj = 0; bj < 2; ++bj) {
                        const int hd = 2 * (u.pn - 10) + bj;
                        bf16_t* base = vt + ((size_t)((b * 4 + hd) * 32 + (s >> 6)) * 128 + wc * 32 + 8 * fq) * 64 + (s & 63);
#pragma unroll
                        for (int n = 0; n < 2; ++n) {
                            const unsigned w0 = cvt_pk_bf16(acc[ai][bj][m][n][0] * rs, acc[ai][bj][m][n][1] * rs), w1 = cvt_pk_bf16(acc[ai][bj][m][n][2] * rs, acc[ai][bj][m][n][3] * rs);
                            base[(4 * n + 0) * 64] = (bf16_t)(w0 & 0xffffu); base[(4 * n + 1) * 64] = (bf16_t)(w0 >> 16);
                            base[(4 * n + 2) * 64] = (bf16_t)(w1 & 0xffffu); base[(4 * n + 3) * 64] = (bf16_t)(w1 >> 16);
                        }
                    }
                }
            }
    }
};

template <int MODE> struct EpiRes {
    static constexpr bool PERM = false, AFTER_DRAIN = false;
    const float* base; float* out; float alpha; bf16_t* hg; const float* gain; float* ssq; const bf16_t* gate;
    __device__ __forceinline__ void operator()(const f32x4 (&acc)[2][2][4][2], const Unit& u, int wr, int wc, int fr, int fq) const {
        const int col0 = u.pn * BM + wc * 32 + 4 * fq;
#pragma unroll
        for (int ai = 0; ai < 2; ++ai)
#pragma unroll
            for (int m = 0; m < 4; ++m) {
                const int row = u.pm * BM + ai * HALF + wr * 64 + m * 16 + fr; const size_t off = (size_t)row * DM + col0;
                float ss = 0.f;
#pragma unroll
                for (int bj = 0; bj < 2; ++bj)
#pragma unroll
                    for (int n = 0; n < 2; ++n) {
                        const int co = bj * HALF + n * 16;
                        const f32x4 bs = *(const f32x4*)(base + off + co);
                        f32x4 h;
                        if (MODE == 0) h = bs + acc[ai][bj][m][n] * alpha;
                        else { const u32x2 gw = *(const u32x2*)(gate + off + co);
                               f32x4 gv; gv[0] = __uint_as_float(gw.x << 16); gv[1] = __uint_as_float(gw.x & 0xffff0000u); gv[2] = __uint_as_float(gw.y << 16); gv[3] = __uint_as_float(gw.y & 0xffff0000u);
                               h = bs + acc[ai][bj][m][n] * gv; }
                        *(f32x4*)(out + off + co) = h;
                        if (MODE == 0) ss += (h[0] * h[0] + h[1] * h[1]) + (h[2] * h[2] + h[3] * h[3]);
                        if (MODE == 0) { const f32x4 gn = *(const f32x4*)(gain + col0 + co); const f32x4 hv = h * gn;
                            u32x2 w; w.x = cvt_pk_bf16(hv[0], hv[1]); w.y = cvt_pk_bf16(hv[2], hv[3]); *(u32x2*)(hg + off + co) = w; }
                        if (MODE == 1) asm volatile("" ::: "memory");
                    }
                if (MODE == 0) { ss += __shfl_xor(ss, 16); ss += __shfl_xor(ss, 32);
                    if (fq == 0) atomicAdd(ssq + row, ss); }
                if (m & 1) asm volatile("" ::: "memory");
            }
    }
};

template <class Epi, class Sched, bool ALIGN_EPI = false, bool SP2 = false>
__device__ __forceinline__ void gemm_phase(PG8_LAS unsigned char* lds, const Gemm g, const Sched& S, const Epi& E) {
    const int tid = threadIdx.x, wid = __builtin_amdgcn_readfirstlane(tid >> 6), lane = tid & 63, wr = wid >> 2, wc = wid & 3, fr = lane & 15, fq = lane >> 4;
    const int K = g.K, nt = K / BK;
    unsigned voffA[2], voffB[2];
#pragma unroll
    for (int i = 0; i < 2; ++i) { int R, C; stage_rc(tid * 16 + i * 8192, R, C); const int Rb = Epi::PERM ? ((R & ~31) + perm32(R & 31)) : R;
        voffA[i] = (unsigned)(R * K + C) * 2u; voffB[i] = (unsigned)(Rb * K + C) * 2u; }
    const size_t kstep = (size_t)(BK * 2);
    const size_t hstep = (size_t)HALF * K * 2;
    const size_t tstep = 2 * hstep;
    const unsigned ldsw = (unsigned)wid * 1024u;
    const int aoff = lds_byte(wr * 64 + fr, fq * 8), boff = lds_byte(wc * 32 + fr, fq * 8);
#define PG8_SA(b, h) (((b) * 2 + (h)) * HTB)
#define PG8_SB(b, h) ((4 + (b) * 2 + (h)) * HTB)
#define PG8_STAGE(bufoff, gbase, voff) do { _Pragma("unroll") for (int _i = 0; _i < 2; ++_i) \
        __builtin_amdgcn_global_load_lds((const unsigned*)((const char*)(gbase) + (voff)[_i]), (PG8_LAS unsigned*)(lds + (bufoff) + ldsw + _i * 8192), 16, 0, 0); } while (0)
#define PG8_LDA(dst, b, h) do { _Pragma("unroll") for (int m = 0; m < 4; ++m) _Pragma("unroll") for (int k = 0; k < 2; ++k) dst[m][k] = *(const PG8_LAS bf16x8*)(lds + PG8_SA(b, h) + aoff + m * 2048 + k * 1024); } while (0)
#define PG8_LDB(dst, b, h) do { _Pragma("unroll") for (int n = 0; n < 2; ++n) _Pragma("unroll") for (int k = 0; k < 2; ++k) dst[n][k] = *(const PG8_LAS bf16x8*)(lds + PG8_SB(b, h) + boff + n * 2048 + k * 1024); } while (0)
#define PG8_MMA(ai, bj, At, Bt) do { __builtin_amdgcn_s_setprio(1); _Pragma("unroll") for (int m = 0; m < 4; ++m) _Pragma("unroll") for (int n = 0; n < 2; ++n) _Pragma("unroll") for (int k = 0; k < 2; ++k) \
        acc[ai][bj][m][n] = __builtin_amdgcn_mfma_f32_16x16x32_bf16(Bt[n][k], At[m][k], acc[ai][bj][m][n], 0, 0, 0); __builtin_amdgcn_s_setprio(0); } while (0)
#define PG8_WAIT_V(n) asm volatile("s_waitcnt vmcnt(" #n ")" ::: "memory")
#define PG8_WAIT_L(n) asm volatile("s_waitcnt lgkmcnt(" #n ")" ::: "memory")
#define PG8_BAR __builtin_amdgcn_s_barrier()
#define PG8_SCHED __builtin_amdgcn_sched_barrier(0)
    Unit cur, nxt; int ui = 0;
    if (!S.next(0, cur)) return;
    f32x4 acc[2][2][4][2];
#pragma unroll
    for (int a = 0; a < 2; ++a)
#pragma unroll
        for (int b = 0; b < 2; ++b)
#pragma unroll
            for (int m = 0; m < 4; ++m)
#pragma unroll
                for (int n = 0; n < 2; ++n) acc[a][b][m][n] = (f32x4){0.f, 0.f, 0.f, 0.f};
    bf16x8 At[4][2], B0[2][2], B1[2][2];
    const char* cA = (const char*)g.A + (size_t)cur.pm * tstep; const char* cB = (const char*)g.Bt + (size_t)cur.pn * tstep;
    S.a_ready(cur);
    if constexpr (SP2) {
        PG8_STAGE(PG8_SB(0, 0), cB, voffB); PG8_STAGE(PG8_SB(0, 1), cB + hstep, voffB); PG8_STAGE(PG8_SA(0, 0), cA, voffA); PG8_STAGE(PG8_SA(0, 1), cA + hstep, voffA);
        if (wr == 1) PG8_BAR;
        PG8_WAIT_V(2); PG8_BAR;
        PG8_STAGE(PG8_SB(1, 0), cB + kstep, voffB); PG8_STAGE(PG8_SA(1, 0), cA + kstep, voffA); PG8_STAGE(PG8_SB(1, 1), cB + hstep + kstep, voffB);
        PG8_WAIT_V(6); PG8_BAR;
    } else {
        PG8_STAGE(PG8_SB(0, 0), cB, voffB); PG8_STAGE(PG8_SA(0, 0), cA, voffA); PG8_STAGE(PG8_SB(0, 1), cB + hstep, voffB); PG8_STAGE(PG8_SA(0, 1), cA + hstep, voffA);
        if (wr == 1) PG8_BAR;
        PG8_WAIT_V(4); PG8_BAR;
        PG8_STAGE(PG8_SB(1, 0), cB + kstep, voffB); PG8_STAGE(PG8_SA(1, 0), cA + kstep, voffA); PG8_STAGE(PG8_SB(1, 1), cB + hstep + kstep, voffB);
        PG8_WAIT_V(6); PG8_BAR;
    }
    for (;;) {
        const bool has_next = S.next(ui + 1, nxt);
        const char* nA = has_next ? (const char*)g.A + (size_t)nxt.pm * tstep : cA; const char* nB = has_next ? (const char*)g.Bt + (size_t)nxt.pn * tstep : cB;
        for (int t = 0; t < nt; t += 2) {
            const bool last = (t == nt - 2);
            const char* a1 = cA + (size_t)(t + 1) * kstep;
            const char* a2 = last ? nA : cA + (size_t)(t + 2) * kstep; const char* b2 = last ? nB : cB + (size_t)(t + 2) * kstep;
            const char* a3 = a2 + kstep; const char* b3 = b2 + kstep;
            if (last && has_next) S.a_ready(nxt);
            if constexpr (SP2) {
            PG8_LDB(B0, 0, 0); PG8_LDB(B1, 0, 1); PG8_SCHED; PG8_LDA(At, 0, 0); PG8_STAGE(PG8_SA(1, 1), a1 + hstep, voffA);
            PG8_WAIT_V(8); PG8_WAIT_L(0); PG8_BAR; PG8_MMA(0, 0, At, B0); PG8_MMA(0, 1, At, B1); PG8_BAR; PG8_SCHED;
            PG8_LDA(At, 0, 1); PG8_STAGE(PG8_SB(0, 0), b2, voffB); PG8_STAGE(PG8_SB(0, 1), b2 + hstep, voffB); PG8_STAGE(PG8_SA(0, 0), a2, voffA);
            PG8_WAIT_V(8); PG8_WAIT_L(0); PG8_BAR; PG8_MMA(1, 0, At, B0); PG8_MMA(1, 1, At, B1); PG8_BAR; PG8_SCHED;
            PG8_LDB(B0, 1, 0); PG8_LDB(B1, 1, 1); PG8_SCHED; PG8_LDA(At, 1, 0); PG8_STAGE(PG8_SA(0, 1), a2 + hstep, voffA);
            PG8_WAIT_V(8); PG8_WAIT_L(0); PG8_BAR; PG8_MMA(0, 0, At, B0); PG8_MMA(0, 1, At, B1); PG8_BAR; PG8_SCHED;
            PG8_LDA(At, 1, 1); PG8_STAGE(PG8_SB(1, 0), b3, voffB); PG8_STAGE(PG8_SB(1, 1), b3 + hstep, voffB); PG8_STAGE(PG8_SA(1, 0), a3, voffA);
            PG8_WAIT_V(8); PG8_WAIT_L(0); PG8_BAR; PG8_MMA(1, 0, At, B0); PG8_MMA(1, 1, At, B1); PG8_BAR; PG8_SCHED;
            } else {
            PG8_LDB(B0, 0, 0); PG8_SCHED; PG8_LDA(At, 0, 0); PG8_STAGE(PG8_SA(1, 1), a1 + hstep, voffA);
            PG8_WAIT_L(8); PG8_BAR; PG8_WAIT_L(0); PG8_MMA(0, 0, At, B0); PG8_BAR; PG8_SCHED;
            PG8_LDB(B1, 0, 1); PG8_STAGE(PG8_SB(0, 0), b2, voffB);
            PG8_BAR; PG8_WAIT_L(0); PG8_MMA(0, 1, At, B1); PG8_BAR;
            PG8_LDA(At, 0, 1); PG8_STAGE(PG8_SA(0, 0), a2, voffA);
            PG8_BAR; PG8_WAIT_L(0); PG8_MMA(1, 0, At, B0); PG8_BAR; PG8_SCHED;
            PG8_STAGE(PG8_SB(0, 1), b2 + hstep, voffB);
            PG8_WAIT_V(6); PG8_BAR; PG8_MMA(1, 1, At, B1); PG8_BAR;
            PG8_LDB(B0, 1, 0); PG8_SCHED; PG8_LDA(At, 1, 0); PG8_STAGE(PG8_SA(0, 1), a2 + hstep, voffA);
            PG8_WAIT_L(8); PG8_BAR; PG8_WAIT_L(0); PG8_MMA(0, 0, At, B0); PG8_BAR; PG8_SCHED;
            PG8_LDB(B1, 1, 1); PG8_STAGE(PG8_SB(1, 0), b3, voffB);
            PG8_BAR; PG8_WAIT_L(0); PG8_MMA(0, 1, At, B1); PG8_BAR;
            PG8_LDA(At, 1, 1); PG8_STAGE(PG8_SA(1, 0), a3, voffA);
            PG8_BAR; PG8_WAIT_L(0); PG8_MMA(1, 0, At, B0); PG8_BAR; PG8_SCHED;
            PG8_STAGE(PG8_SB(1, 1), b3 + hstep, voffB);
            PG8_WAIT_V(6); PG8_BAR; PG8_MMA(1, 1, At, B1); PG8_BAR;
            }
        }
        if constexpr (ALIGN_EPI) { if (wr == 0) PG8_BAR; }
        if constexpr (!Epi::AFTER_DRAIN) { E(acc, cur, wr, wc, fr, fq); S.done(cur); }
        if (!has_next) break;
#pragma unroll
        for (int a = 0; a < 2; ++a)
#pragma unroll
            for (int b = 0; b < 2; ++b)
#pragma unroll
                for (int m = 0; m < 4; ++m)
#pragma unroll
                    for (int n = 0; n < 2; ++n) acc[a][b][m][n] = (f32x4){0.f, 0.f, 0.f, 0.f};
        cur = nxt; cA = nA; cB = nB; ++ui;
        if constexpr (ALIGN_EPI) { if (wr == 1) PG8_BAR; }
    }
    PG8_WAIT_V(0);
    if constexpr (!ALIGN_EPI) { if (wr == 0) PG8_BAR; }
    PG8_BAR;
    if constexpr (Epi::AFTER_DRAIN) { E.fused(acc, cur, wr, wc, fr, fq, lds, wid, lane); S.done(cur); }
#undef PG8_SA
#undef PG8_SB
#undef PG8_STAGE
#undef PG8_LDA
#undef PG8_LDB
#undef PG8_MMA
#undef PG8_WAIT_V
#undef PG8_WAIT_L
#undef PG8_BAR
#undef PG8_SCHED
}
}

#define LAS __attribute__((address_space(3)))
typedef unsigned short bf16_t;
typedef short bf16x8 __attribute__((ext_vector_type(8)));
typedef float f32x4 __attribute__((ext_vector_type(4)));
typedef float f32x16 __attribute__((ext_vector_type(16)));
typedef unsigned u32x4 __attribute__((ext_vector_type(4)));
typedef unsigned u32x2 __attribute__((ext_vector_type(2)));
using pg8::cvt_pk_bf16;
__device__ __forceinline__ float bf_lo(unsigned w) { return __uint_as_float(w << 16); }
__device__ __forceinline__ float bf_hi(unsigned w) { return __uint_as_float(w & 0xffff0000u); }
__device__ __forceinline__ float silu_f(float x) { return x * pg8::sigmoid_f(x); }
__device__ __forceinline__ float ex2(float x) { return __builtin_amdgcn_exp2f(x); }
__device__ __forceinline__ float exn(float x) { return __builtin_amdgcn_exp2f(x * LOG2E); }

constexpr size_t MiB = 1u << 20;
constexpr size_t WS_CTL = 0, CTL_ZERO_BYTES = 1 * MiB;
constexpr size_t CTL_SSQ = 64 * 1024;
constexpr int CW_BAR = 1024;
constexpr size_t WS_W1A = 2 * MiB, WS_W2A = 13 * MiB, WS_WIN = 19 * MiB, WS_WOUT = 26 * MiB, WS_W1B = 28 * MiB, WS_W2B = 39 * MiB, WS_WG = 45 * MiB, WS_WP = 47 * MiB;
constexpr size_t WS_HG = 64 * MiB;
constexpr size_t WS_ACT = 128 * MiB;
constexpr size_t WS_KT = 256 * MiB;
constexpr size_t WS_VT = 304 * MiB;
constexpr size_t WS_GATES = 336 * MiB;
constexpr size_t WS_HBUF = 338 * MiB;
constexpr size_t WS_MIX = 402 * MiB;
constexpr size_t WS_PB = 466 * MiB;
constexpr size_t WS_END = 482 * MiB;

constexpr int LDS_BYTES = 147456;
constexpr int LDS_CTLW = 143360;

__device__ __forceinline__ void transpose_item(const float* W, int K, int ldw, int k0, int nsrc0, int nvalid, bf16_t* WTrow0, LAS float* scr, int lane) {
#pragma unroll 8
    for (int i = 0; i < 32; ++i) { const int kk = 2 * i + (lane >> 5); const int c = lane & 31;
        scr[kk * 33 + c] = (c < nvalid) ? W[(size_t)(k0 + kk) * ldw + nsrc0 + c] : 0.f; }
    asm volatile("s_waitcnt lgkmcnt(0)" ::: "memory");
    const int c = lane & 7;
#pragma unroll
    for (int j = 0; j < 4; ++j) { const int n = (lane >> 3) + 8 * j; const LAS float* s = scr + (8 * c) * 33 + n;
        u32x4 o; o.x = cvt_pk_bf16(s[0 * 33], s[1 * 33]); o.y = cvt_pk_bf16(s[2 * 33], s[3 * 33]); o.z = cvt_pk_bf16(s[4 * 33], s[5 * 33]); o.w = cvt_pk_bf16(s[6 * 33], s[7 * 33]);
        *(u32x4*)(WTrow0 + (size_t)n * K + k0 + 8 * c) = o; }
    asm volatile("s_waitcnt lgkmcnt(0)" ::: "memory");
}
__device__ __forceinline__ float wave_sum(float v) {
#pragma unroll
    for (int o = 1; o < 64; o <<= 1) v += __shfl_xor(v, o);
    return v;
}

struct Args { const float* in[23]; float* out; unsigned char* ws; int ph_lo, ph_hi; };

__device__ __forceinline__ void p0_prologue(const Args& a, LAS unsigned char* lds, int gw, int NGW, int wave, int lane) {
    LAS float* scr = (LAS float*)(lds + wave * 16384);
    unsigned char* ws = a.ws;
    constexpr int I_1 = 16 * 176, I_2 = 44 * 32, I_IN = 16 * 97, I_SQ = 16 * 32, I_P = 4 * 32;
    constexpr int NITEMS = 2 * I_1 + 2 * I_2 + I_IN + 2 * I_SQ + I_P;
    for (int it = gw; it < NITEMS; it += NGW) {
        int r = it;
        if (r < 2 * I_1) {
            const int f = r >= I_1; r -= f * I_1; const int kb = r / 176, nb = r % 176, n0 = nb * 32;
            const int pn = n0 >> 8, rem = n0 & 255, half = rem >> 7, i = rem & 127;
            transpose_item(a.in[f ? 17 : 3], DM, 2 * DFF, kb * 64, half * DFF + 128 * pn + i, 32, (bf16_t*)(ws + (f ? WS_W1B : WS_W1A)) + (size_t)n0 * DM, scr, lane); continue; }
        r -= 2 * I_1;
        if (r < 2 * I_2) {
            const int f = r >= I_2; r -= f * I_2; const int kb = r / 32, nb = r % 32;
            transpose_item(a.in[f ? 18 : 4], DFF, DM, kb * 64, nb * 32, 32, (bf16_t*)(ws + (f ? WS_W2B : WS_W2A)) + (size_t)(nb * 32) * DFF, scr, lane); continue; }
        r -= 2 * I_2;
        if (r < I_IN) {
            const int kb = r / 97, nb = r % 97, n0 = nb * 32; int ns, nv;
            if (n0 < 1536) { ns = n0; nv = 32; } else if (n0 < 3072) { ns = n0 + 16; nv = 32; } else if (n0 == 3072) { ns = 1536; nv = 16; } else { ns = 0; nv = 0; }
            transpose_item(a.in[6], DM, DIN, kb * 64, ns, nv, (bf16_t*)(ws + WS_WIN) + (size_t)n0 * DM, scr, lane); continue; }
        r -= I_IN;
        if (r < 2 * I_SQ) {
            const int f = r >= I_SQ; r -= f * I_SQ; const int kb = r / 32, nb = r % 32;
            transpose_item(a.in[f ? 20 : 15], DM, DM, kb * 64, nb * 32, 32, (bf16_t*)(ws + (f ? WS_WG : WS_WOUT)) + (size_t)(nb * 32) * DM, scr, lane); continue; }
        r -= 2 * I_SQ;
        { const int kb = r / 32, nb = r % 32;
          transpose_item(a.in[21], PLE, DM, kb * 64, nb * 32, 32, (bf16_t*)(ws + WS_WP) + (size_t)(nb * 32) * PLE, scr, lane); }
    }
    const float* x = a.in[0]; const float* g1 = a.in[2]; const float* p = a.in[1];
    bf16_t* hg = (bf16_t*)(ws + WS_HG); float* ssq0 = (float*)(ws + WS_CTL + CTL_SSQ); bf16_t* pb = (bf16_t*)(ws + WS_PB);
    f32x4 gv[4];
#pragma unroll
    for (int j = 0; j < 4; ++j) gv[j] = *((const f32x4*)g1 + lane + 64 * j);
    for (int m = gw; m < MTOK; m += NGW) {
        const f32x4* xr = (const f32x4*)(x + (size_t)m * DM) + lane; float s = 0.f;
        unsigned long long* o8 = (unsigned long long*)(hg + (size_t)m * DM) + lane;
#pragma unroll
        for (int j = 0; j < 4; ++j) { const f32x4 v = xr[64 * j]; s += (v[0] * v[0] + v[1] * v[1]) + (v[2] * v[2] + v[3] * v[3]); const f32x4 h = v * gv[j];
            o8[64 * j] = (unsigned long long)cvt_pk_bf16(h[0], h[1]) | ((unsigned long long)cvt_pk_bf16(h[2], h[3]) << 32); }
        s = wave_sum(s); if (lane == 0) ssq0[m] = s;
        const f32x4 pv = *((const f32x4*)(p + (size_t)m * PLE) + lane);
        *((unsigned long long*)(pb + (size_t)m * PLE) + lane) = (unsigned long long)cvt_pk_bf16(pv[0], pv[1]) | ((unsigned long long)cvt_pk_bf16(pv[2], pv[3]) << 32);
    }
}

namespace att {
constexpr int KP = 272, VP = 144, KTB = 64 * KP, VTB = 128 * VP;
constexpr int OFF_K = 0, OFF_V = 2 * KTB;
static_assert(OFF_V + 3 * VTB <= LDS_CTLW, "attention LDS");

__device__ __forceinline__ float a_add(float a, float b) { float r; asm volatile("v_add_f32_e32 %0, %1, %2" : "=v"(r) : "v"(a), "v"(b)); return r; }
__device__ __forceinline__ float a_add_s(float a, float sc) { float r; asm volatile("v_add_f32_e32 %0, %2, %1" : "=v"(r) : "v"(a), "s"(sc)); return r; }
__device__ __forceinline__ float a_fma(float a, float b, float c) { float r; asm volatile("v_fma_f32 %0, %1, %2, %3" : "=v"(r) : "v"(a), "v"(b), "v"(c)); return r; }
__device__ __forceinline__ float a_fma_abs(float a, float b, float c) { float r; asm volatile("v_fma_f32 %0, %1, |%2|, %3" : "=v"(r) : "v"(a), "v"(b), "v"(c)); return r; }
__device__ __forceinline__ float a_max3(float a, float b, float c) { float r; asm volatile("v_max3_f32 %0, %1, %2, %3" : "=v"(r) : "v"(a), "v"(b), "v"(c)); return r; }

#define SM_BIAS4(g)  asm volatile( \
        "v_add_f32_e32 %[t0], %[c0], %[dq]\n\tv_add_f32_e32 %[t1], %[c1], %[dq]\n\tv_add_f32_e32 %[t2], %[c2], %[dq]\n\tv_add_f32_e32 %[t3], %[c3], %[dq]\n\t" \
        "v_add_f32_e32 %[u0], %[c0], %[dr]\n\tv_add_f32_e32 %[u1], %[c1], %[dr]\n\tv_add_f32_e32 %[u2], %[c2], %[dr]\n\tv_add_f32_e32 %[u3], %[c3], %[dr]\n\t" \
        "v_fma_f32 %[a0], %[nk], |%[t0]|, %[a0]\n\tv_fma_f32 %[a1], %[nk], |%[t1]|, %[a1]\n\tv_fma_f32 %[a2], %[nk], |%[t2]|, %[a2]\n\tv_fma_f32 %[a3], %[nk], |%[t3]|, %[a3]\n\t" \
        "v_fma_f32 %[b0], %[nk], |%[u0]|, %[b0]\n\tv_fma_f32 %[b1], %[nk], |%[u1]|, %[b1]\n\tv_fma_f32 %[b2], %[nk], |%[u2]|, %[b2]\n\tv_fma_f32 %[b3], %[nk], |%[u3]|, %[b3]\n\t" \
        "v_max3_f32 %[ma], %[ma], %[a0], %[b0]\n\tv_max3_f32 %[mb], %[mb], %[a1], %[b1]\n\tv_max3_f32 %[ma], %[ma], %[a2], %[b2]\n\tv_max3_f32 %[mb], %[mb], %[a3], %[b3]" \
        : [a0] "+v"(s0[4 * g]), [a1] "+v"(s0[4 * g + 1]), [a2] "+v"(s0[4 * g + 2]), [a3] "+v"(s0[4 * g + 3]), \
          [b0] "+v"(s1[4 * g]), [b1] "+v"(s1[4 * g + 1]), [b2] "+v"(s1[4 * g + 2]), [b3] "+v"(s1[4 * g + 3]), [ma] "+v"(mxa), [mb] "+v"(mxb), \
          [t0] "=&v"(t0), [t1] "=&v"(t1), [t2] "=&v"(t2), [t3] "=&v"(t3), [u0] "=&v"(u0), [u1] "=&v"(u1), [u2] "=&v"(u2), [u3] "=&v"(u3) \
        : [dq] "v"(dq), [dr] "v"(dq32), [nk] "v"(nk2), [c0] "s"(8.0f * g), [c1] "s"(8.0f * g + 1.0f), [c2] "s"(8.0f * g + 2.0f), [c3] "s"(8.0f * g + 3.0f))
#define SM_FMA8(g)  asm volatile( \
        "v_fma_f32 %[a0], %[a0], %[cc], %[nb]\n\tv_fma_f32 %[a1], %[a1], %[cc], %[nb]\n\tv_fma_f32 %[a2], %[a2], %[cc], %[nb]\n\tv_fma_f32 %[a3], %[a3], %[cc], %[nb]\n\t" \
        "v_fma_f32 %[b0], %[b0], %[cc], %[nb]\n\tv_fma_f32 %[b1], %[b1], %[cc], %[nb]\n\tv_fma_f32 %[b2], %[b2], %[cc], %[nb]\n\tv_fma_f32 %[b3], %[b3], %[cc], %[nb]" \
        : [a0] "+v"(s0[4 * g]), [a1] "+v"(s0[4 * g + 1]), [a2] "+v"(s0[4 * g + 2]), [a3] "+v"(s0[4 * g + 3]), \
          [b0] "+v"(s1[4 * g]), [b1] "+v"(s1[4 * g + 1]), [b2] "+v"(s1[4 * g + 2]), [b3] "+v"(s1[4 * g + 3]) \
        : [cc] "v"(c1), [nb] "v"(nb))

__device__ __forceinline__ void softmax_tile(f32x16& s0, f32x16& s1, float& m, float& l, f32x16 (&O)[4], float dq, float c1, float nk2,
                                             bf16x8& p0, bf16x8& p1, bf16x8& p2, bf16x8& p3) {
    asm volatile("s_nop 15\n\ts_nop 7" : "+v"(s0), "+v"(s1));
    const float dq32 = dq + 32.0f;
    float mxa = -INFINITY, mxb = -INFINITY;
    { float t0, t1, t2, t3, u0, u1, u2, u3;
      SM_BIAS4(0); SM_BIAS4(1); SM_BIAS4(2); SM_BIAS4(3); }
    float mx = __builtin_fmaxf(mxa, mxb);
    mx = __builtin_fmaxf(mx, __shfl_xor(mx, 32));
    float alpha = 1.0f;
    const bool grow = __any(mx > m + 8.0f / c1);
    if (grow) { const float mn = __builtin_fmaxf(m, mx); alpha = ex2((m - mn) * c1); m = mn; }
    const float nb = -m * c1;
    SM_FMA8(0); SM_FMA8(1); SM_FMA8(2); SM_FMA8(3);
    float suma = 0.f, sumb = 0.f;
#pragma unroll
    for (int i = 0; i < 16; ++i) { s0[i] = ex2(s0[i]); s1[i] = ex2(s1[i]); suma += s0[i]; sumb += s1[i]; }
    l = l * alpha + (suma + sumb);
    if (grow) {
#pragma unroll
        for (int vt = 0; vt < 4; ++vt)
#pragma unroll
            for (int i = 0; i < 16; ++i) O[vt][i] *= alpha;
    }
    u32x4 w;
    w.x = cvt_pk_bf16(s0[0], s0[1]); w.y = cvt_pk_bf16(s0[2], s0[3]); w.z = cvt_pk_bf16(s0[4], s0[5]); w.w = cvt_pk_bf16(s0[6], s0[7]); p0 = __builtin_bit_cast(bf16x8, w);
    w.x = cvt_pk_bf16(s0[8], s0[9]); w.y = cvt_pk_bf16(s0[10], s0[11]); w.z = cvt_pk_bf16(s0[12], s0[13]); w.w = cvt_pk_bf16(s0[14], s0[15]); p1 = __builtin_bit_cast(bf16x8, w);
    w.x = cvt_pk_bf16(s1[0], s1[1]); w.y = cvt_pk_bf16(s1[2], s1[3]); w.z = cvt_pk_bf16(s1[4], s1[5]); w.w = cvt_pk_bf16(s1[6], s1[7]); p2 = __builtin_bit_cast(bf16x8, w);
    w.x = cvt_pk_bf16(s1[8], s1[9]); w.y = cvt_pk_bf16(s1[10], s1[11]); w.z = cvt_pk_bf16(s1[12], s1[13]); w.w = cvt_pk_bf16(s1[14], s1[15]); p3 = __builtin_bit_cast(bf16x8, w);
}

__device__ __forceinline__ void attn_unit(LAS unsigned char* lds, const bf16_t* zb, const bf16_t* ktg, const bf16_t* vtg, bf16_t* mix, const float* g_anorm, int unit, float lam, float onem) {
    const int tid = threadIdx.x, lane = tid & 63, r = lane & 31, hh = lane >> 5; const int wid = __builtin_amdgcn_readfirstlane(tid >> 6);
    const int map = wid >> 2, wq = wid & 3;
    const int bh = unit >> 4, qb = unit & 15, b = bh >> 2, h = bh & 3;
    const size_t tok0 = (size_t)b * SEQ;
    const bf16_t* kbase = ktg + (size_t)bh * 32 * 8192 + tid * 8;
    const bf16_t* qrow = zb + (tok0 + qb * 128 + 32 * wq + r) * ZLD + 1536 + h * 128 + map * 64 + 8 * hh;
    const bf16_t* vbase = vtg + (size_t)bh * 32 * 8192 + tid * 8;
    bf16x8 qf[4];
#pragma unroll
    for (int ks = 0; ks < 4; ++ks) qf[ks] = *(const bf16x8*)(qrow + 16 * ks);
    u32x4 kr[2], vr[2];
    const int krow0 = tid >> 4, kch = tid & 15, vrow0 = tid >> 3, vch = tid & 7;
#define ATT_LOAD(t) do { _Pragma("unroll") for (int i_ = 0; i_ < 2; ++i_) { \
        kr[i_] = *(const u32x4*)(kbase + (size_t)(t) * 8192 + 4096 * i_); \
        vr[i_] = *(const u32x4*)(vbase + (size_t)(t) * 8192 + 4096 * i_); } } while (0)
#define ATT_STORE(kbuf, vbuf) do { _Pragma("unroll") for (int i_ = 0; i_ < 2; ++i_) { \
        *(LAS u32x4*)(lds + OFF_K + (kbuf) * KTB + (krow0 + 32 * i_) * KP + kch * 16) = kr[i_]; \
        LAS unsigned char* vp_ = lds + OFF_V + (vbuf) * VTB + (vrow0 + 64 * i_) * VP + (vch >> 1) * 32 + (vch & 1) * 8; \
        *(LAS u32x2*)(vp_) = (u32x2){vr[i_].x, vr[i_].y}; *(LAS u32x2*)(vp_ + 16) = (u32x2){vr[i_].z, vr[i_].w}; } } while (0)
    ATT_LOAD(0); ATT_STORE(0, 0); ATT_LOAD(1);
    __syncthreads();
    const float slope = __builtin_amdgcn_exp2f(-2.0f * (float)(h + 1));
    const float c1 = 0.125f * LOG2E, nk2 = -8.0f * slope;
    const float qposf = (float)(qb * 128 + 32 * wq + r);
    f32x16 O[4];
#pragma unroll
    for (int vt = 0; vt < 4; ++vt) O[vt] = (f32x16){};
    float m = -INFINITY, l = 0.f;
    bf16x8 pa[4];
#define ATT_KRD(kf_) do { _Pragma("unroll") for (int i_ = 0; i_ < 8; ++i_) kf_[i_] = *(const LAS bf16x8*)(kp + (i_ >> 2) * 32 * KP + 32 * (i_ & 3)); } while (0)
#define ATT_QK(kf_) do { _Pragma("unroll") for (int ks_ = 0; ks_ < 4; ++ks_) { \
        s0 = __builtin_amdgcn_mfma_f32_32x32x16_bf16(kf_[ks_], qf[ks_], s0, 0, 0, 0); s1 = __builtin_amdgcn_mfma_f32_32x32x16_bf16(kf_[4 + ks_], qf[ks_], s1, 0, 0, 0); } } while (0)
#define ATT_PV(vslot) do { const LAS unsigned char* vp_ = lds + OFF_V + (vslot) * VTB + r * VP + 16 * hh; \
        _Pragma("unroll") for (int ks_ = 0; ks_ < 4; ++ks_) { bf16x8 vf_[4]; \
            _Pragma("unroll") for (int i_ = 0; i_ < 4; ++i_) vf_[i_] = *(const LAS bf16x8*)(vp_ + i_ * 32 * VP + ks_ * 32); \
            _Pragma("unroll") for (int i_ = 0; i_ < 4; ++i_) O[i_] = __builtin_amdgcn_mfma_f32_32x32x16_bf16(vf_[i_], pa[ks_], O[i_], 0, 0, 0); } } while (0)
#define ATT_STAGE(t_) do { const int vb_next_ = vb_cur == 2 ? 0 : vb_cur + 1; \
        if ((t_) + 1 < 32) ATT_STORE(((t_) + 1) & 1, vb_next_); if ((t_) + 2 < 32) ATT_LOAD((t_) + 2); vb_prev = vb_cur; vb_cur = vb_next_; } while (0)
    int vb_cur = 0, vb_prev = 2;
    if (map == 0) {
        for (int t = 0; t < 32; ++t) {
            const LAS unsigned char* kp = lds + OFF_K + (t & 1) * KTB + r * KP + 16 * hh;
            const float dq = (float)(t * 64 + 4 * hh) - qposf;
            f32x16 s0 = (f32x16){}, s1 = (f32x16){};
            { bf16x8 kf[8]; ATT_KRD(kf); ATT_QK(kf); }
            __builtin_amdgcn_sched_barrier(0);
            softmax_tile(s0, s1, m, l, O, dq, c1, nk2, pa[0], pa[1], pa[2], pa[3]);
            __builtin_amdgcn_sched_barrier(0);
            __syncthreads();
            ATT_PV(vb_cur);
            ATT_STAGE(t);
            __syncthreads();
        }
    } else {
        for (int t = 0; t < 32; ++t) {
            const LAS unsigned char* kp = lds + OFF_K + (t & 1) * KTB + r * KP + 16 * hh + 128;
            const float dq = (float)(t * 64 + 4 * hh) - qposf;
            f32x16 s0 = (f32x16){}, s1 = (f32x16){};
            if (t > 0) ATT_PV(vb_prev);
            { bf16x8 kf[8]; ATT_KRD(kf); ATT_QK(kf); }
            __syncthreads();
            __builtin_amdgcn_sched_barrier(0);
            softmax_tile(s0, s1, m, l, O, dq, c1, nk2, pa[0], pa[1], pa[2], pa[3]);
            __builtin_amdgcn_sched_barrier(0);
            ATT_STAGE(t);
            __syncthreads();
        }
        ATT_PV(vb_prev);
    }
    __syncthreads();
#undef ATT_STAGE
#undef ATT_KRD
#undef ATT_QK
#undef ATT_PV
#undef ATT_LOAD
#undef ATT_STORE
    l += __shfl_xor(l, 32);
    LAS float* xb = (LAS float*)(lds) + wq * 4096 + lane;
    if (map == 1) {
        const float sc = lam / l;
#pragma unroll
        for (int vt = 0; vt < 4; ++vt)
#pragma unroll
            for (int i = 0; i < 16; ++i) xb[(vt * 16 + i) * 64] = O[vt][i] * sc;
    }
    __syncthreads();
    if (map == 0) {
        const float inv1 = 1.0f / l;
        float ss = 0.f;
#pragma unroll
        for (int vt = 0; vt < 4; ++vt)
#pragma unroll
            for (int i = 0; i < 16; ++i) { const float o = O[vt][i] * inv1 - xb[(vt * 16 + i) * 64]; O[vt][i] = o; ss += o * o; }
        ss += __shfl_xor(ss, 32);
        const float rn = (1.0f / __builtin_sqrtf(ss * (1.0f / 128.0f) + EPS)) * onem;
        bf16_t* orow = mix + (tok0 + qb * 128 + 32 * wq + r) * DM + 512 + h * 128;
#pragma unroll
        for (int vt = 0; vt < 4; ++vt)
#pragma unroll
            for (int g4 = 0; g4 < 4; ++g4) { const int v0 = 32 * vt + 8 * g4 + 4 * hh; const f32x4 gn = *(const f32x4*)(g_anorm + h * 128 + v0);
                u32x2 w; w.x = cvt_pk_bf16(O[vt][4 * g4 + 0] * rn * gn[0], O[vt][4 * g4 + 1] * rn * gn[1]); w.y = cvt_pk_bf16(O[vt][4 * g4 + 2] * rn * gn[2], O[vt][4 * g4 + 3] * rn * gn[3]);
                *(u32x2*)(orow + v0) = w; }
    }
    __syncthreads();
}
}

namespace mls {
constexpr int P = 144;
constexpr int QS = 0, KS = 9216, KW = 18432, PS = 27648, VT = 36864, CT = 59904, SD = 82944, SCA = 83200, SCM = SCA + 8192, SCB = SCM + 8192, END = SCB + 8192;
static_assert(END <= LDS_CTLW, "mLSTM LDS");
__device__ __forceinline__ bf16x8 ldfrag(const LAS unsigned char* base, int row, int ks, int fq) { return *(const LAS bf16x8*)(base + row * P + ks * 64 + fq * 16); }

__device__ __forceinline__ void chain(LAS unsigned char* lds, const bf16_t* zb, const float* gates, const float* conv_w, bf16_t* hbuf, int chain_id) {
    const int tid = threadIdx.x, lane = tid & 63, fr = lane & 15, fq = lane >> 4; const int wid = __builtin_amdgcn_readfirstlane(tid >> 6);
    const int dir = chain_id & 1, bh = chain_id >> 1, b = bh >> 2, h = bh & 3;
    const int rb = wid & 3, cg5 = wid >> 2;
    LAS float* sden = (LAS float*)(lds + SD); LAS float* scA = (LAS float*)(lds + SCA); LAS float* scM = (LAS float*)(lds + SCM); LAS float* scB = (LAS float*)(lds + SCB);
    for (int i = tid; i < 160 * (P / 4); i += 512) ((LAS unsigned*)(lds + CT))[i] = 0u;
    for (int i = tid; i < 32 * (P / 4); i += 512) ((LAS unsigned*)(lds + VT + 128 * P))[i] = (i < (P / 4)) ? 0x3F803F80u : 0u;
    for (int cc = wid; cc < 32; cc += 8) {
        const int sl = dir ? (SEQ - 1 - (64 * cc + lane)) : (64 * cc + lane);
        const float* gr = gates + ((size_t)b * SEQ + sl) * 16 + (2 * dir) * 4 + h;
        const float gi = gr[0], gf = gr[4];
        const float lf = __builtin_fminf(gf, 0.f) - log1pf(expf(-__builtin_fabsf(gf)));
        float bs = lf;
#pragma unroll
        for (int o = 1; o < 64; o <<= 1) { const float t2 = __shfl_up(bs, o); if (lane >= o) bs += t2; }
        const float av = gi - bs; float am = av;
#pragma unroll
        for (int o = 1; o < 64; o <<= 1) { const float t2 = __shfl_up(am, o); if (lane >= o) am = __builtin_fmaxf(am, t2); }
        scA[cc * 64 + lane] = av; scM[cc * 64 + lane] = am; scB[cc * 64 + lane] = bs;
    }
    f32x4 C[5];
#pragma unroll
    for (int i = 0; i < 5; ++i) C[i] = (f32x4){0.f, 0.f, 0.f, 0.f};
    float m = 0.f;
    const int t_ld = tid >> 3, c8 = tid & 7;
    const u32x4 zero4 = (u32x4){0u, 0u, 0u, 0u};
    u32x4 q0, k0, qm, km, qp, kp, v0, v1;
#define MLS_LOAD(c_) do { const int sg_ = dir ? (SEQ - 1 - (64 * (c_) + t_ld)) : (64 * (c_) + t_ld); const bf16_t* zrow_ = zb + ((size_t)b * SEQ + sg_) * ZLD; \
        q0 = *(const u32x4*)(zrow_ + h * 64 + 8 * c8); k0 = *(const u32x4*)(zrow_ + 256 + h * 64 + 8 * c8); \
        qm = sg_ > 0 ? *(const u32x4*)(zrow_ - ZLD + h * 64 + 8 * c8) : zero4; km = sg_ > 0 ? *(const u32x4*)(zrow_ - ZLD + 256 + h * 64 + 8 * c8) : zero4; \
        qp = sg_ < SEQ - 1 ? *(const u32x4*)(zrow_ + ZLD + h * 64 + 8 * c8) : zero4; kp = sg_ < SEQ - 1 ? *(const u32x4*)(zrow_ + ZLD + 256 + h * 64 + 8 * c8) : zero4; \
        v0 = *(const u32x4*)(zrow_ + 512 + h * 128 + 16 * c8); v1 = *(const u32x4*)(zrow_ + 512 + h * 128 + 16 * c8 + 8); } while (0)
    MLS_LOAD(0);
    const float* cw = conv_w + h * 64 + 8 * c8;
    __syncthreads();
    for (int c = 0; c < 32; ++c) {
        const float M63 = __builtin_fmaxf(m, scM[c * 64 + 63]), bl = scB[c * 64 + 63];
        {
            const float wkt = exn(scA[c * 64 + t_ld] - M63);
            float qv[8], kv[8];
#pragma unroll
            for (int e4 = 0; e4 < 2; ++e4) {
                const f32x4 wq0 = *(const f32x4*)(cw + 4 * e4), wq1 = *(const f32x4*)(cw + 512 + 4 * e4), wq2 = *(const f32x4*)(cw + 1024 + 4 * e4);
                const f32x4 wk0 = *(const f32x4*)(cw + 256 + 4 * e4), wk1 = *(const f32x4*)(cw + 768 + 4 * e4), wk2 = *(const f32x4*)(cw + 1280 + 4 * e4);
#pragma unroll
                for (int e2 = 0; e2 < 2; ++e2) {
                    const int wi = 2 * e4 + e2;
                    const unsigned a_m = qm[wi], a_0 = q0[wi], a_p = qp[wi], b_m = km[wi], b_0 = k0[wi], b_p = kp[wi];
                    const float ql = wq0[2 * e2] * bf_lo(a_m) + wq1[2 * e2] * bf_lo(a_0) + wq2[2 * e2] * bf_lo(a_p);
                    const float qh = wq0[2 * e2 + 1] * bf_hi(a_m) + wq1[2 * e2 + 1] * bf_hi(a_0) + wq2[2 * e2 + 1] * bf_hi(a_p);
                    const float kl = wk0[2 * e2] * bf_lo(b_m) + wk1[2 * e2] * bf_lo(b_0) + wk2[2 * e2] * bf_lo(b_p);
                    const float kh = wk0[2 * e2 + 1] * bf_hi(b_m) + wk1[2 * e2 + 1] * bf_hi(b_0) + wk2[2 * e2 + 1] * bf_hi(b_p);
                    qv[2 * wi] = silu_f(ql); qv[2 * wi + 1] = silu_f(qh); kv[2 * wi] = silu_f(kl) * 0.125f; kv[2 * wi + 1] = silu_f(kh) * 0.125f;
                }
            }
            u32x4 w;
            w.x = cvt_pk_bf16(qv[0], qv[1]); w.y = cvt_pk_bf16(qv[2], qv[3]); w.z = cvt_pk_bf16(qv[4], qv[5]); w.w = cvt_pk_bf16(qv[6], qv[7]);
            *(LAS u32x4*)(lds + QS + t_ld * P + c8 * 16) = w;
            w.x = cvt_pk_bf16(kv[0], kv[1]); w.y = cvt_pk_bf16(kv[2], kv[3]); w.z = cvt_pk_bf16(kv[4], kv[5]); w.w = cvt_pk_bf16(kv[6], kv[7]);
            *(LAS u32x4*)(lds + KS + t_ld * P + c8 * 16) = w;
#pragma unroll
            for (int e = 0; e < 8; e += 2) { const unsigned pk = cvt_pk_bf16(kv[e] * wkt, kv[e + 1] * wkt);
                *(LAS bf16_t*)(lds + KW + (8 * c8 + e) * P + t_ld * 2) = (bf16_t)(pk & 0xffffu); *(LAS bf16_t*)(lds + KW + (8 * c8 + e + 1) * P + t_ld * 2) = (bf16_t)(pk >> 16); }
#pragma unroll
            for (int e = 0; e < 4; ++e) {
                *(LAS bf16_t*)(lds + VT + (16 * c8 + 2 * e) * P + t_ld * 2) = (bf16_t)(v0[e] & 0xffffu); *(LAS bf16_t*)(lds + VT + (16 * c8 + 2 * e + 1) * P + t_ld * 2) = (bf16_t)(v0[e] >> 16);
                *(LAS bf16_t*)(lds + VT + (16 * c8 + 8 + 2 * e) * P + t_ld * 2) = (bf16_t)(v1[e] & 0xffffu); *(LAS bf16_t*)(lds + VT + (16 * c8 + 8 + 2 * e + 1) * P + t_ld * 2) = (bf16_t)(v1[e] >> 16); }
        }
        if (c + 1 < 32) MLS_LOAD(c + 1);
        __syncthreads();
        const bf16x8 qa0 = ldfrag(lds + QS, 16 * rb + fr, 0, fq), qa1 = ldfrag(lds + QS, 16 * rb + fr, 1, fq);
        float Mt[4], bt[4];
#pragma unroll
        for (int j = 0; j < 4; ++j) { Mt[j] = __builtin_fmaxf(m, scM[c * 64 + 16 * rb + 4 * fq + j]); bt[j] = scB[c * 64 + 16 * rb + 4 * fq + j]; }
        {
#pragma unroll
            for (int si = 0; si < 2; ++si) { const int sbk = 2 * cg5 + si; f32x4 acc = (f32x4){0.f, 0.f, 0.f, 0.f};
                if (sbk <= rb) {
                    acc = __builtin_amdgcn_mfma_f32_16x16x32_bf16(qa0, ldfrag(lds + KS, 16 * sbk + fr, 0, fq), acc, 0, 0, 0);
                    acc = __builtin_amdgcn_mfma_f32_16x16x32_bf16(qa1, ldfrag(lds + KS, 16 * sbk + fr, 1, fq), acc, 0, 0, 0);
                    const int s = 16 * sbk + fr; const float as = scA[c * 64 + s];
#pragma unroll
                    for (int j = 0; j < 4; ++j) { const int t = 16 * rb + 4 * fq + j; acc[j] = (s <= t) ? acc[j] * exn(as - Mt[j]) : 0.f; }
                }
                const unsigned w0 = cvt_pk_bf16(acc[0], acc[1]), w1 = cvt_pk_bf16(acc[2], acc[3]);
                LAS unsigned char* pp = lds + PS + (16 * rb + 4 * fq) * P + (16 * sbk + fr) * 2;
                *(LAS bf16_t*)(pp) = (bf16_t)(w0 & 0xffffu); *(LAS bf16_t*)(pp + P) = (bf16_t)(w0 >> 16); *(LAS bf16_t*)(pp + 2 * P) = (bf16_t)(w1 & 0xffffu); *(LAS bf16_t*)(pp + 3 * P) = (bf16_t)(w1 >> 16);
            }
        }
        {
            const float decay = exn(m - M63);
            const bf16x8 ka0 = ldfrag(lds + KW, 16 * rb + fr, 0, fq), ka1 = ldfrag(lds + KW, 16 * rb + fr, 1, fq);
#pragma unroll
            for (int i = 0; i < 5; ++i) { const int vt = 5 * cg5 + i;
                C[i] = C[i] * decay;
                C[i] = __builtin_amdgcn_mfma_f32_16x16x32_bf16(ka0, ldfrag(lds + VT, 16 * vt + fr, 0, fq), C[i], 0, 0, 0);
                C[i] = __builtin_amdgcn_mfma_f32_16x16x32_bf16(ka1, ldfrag(lds + VT, 16 * vt + fr, 1, fq), C[i], 0, 0, 0); }
        }
        __syncthreads();
        f32x4 N[5];
        {
            const bf16x8 pa0 = ldfrag(lds + PS, 16 * rb + fr, 0, fq), pa1 = ldfrag(lds + PS, 16 * rb + fr, 1, fq);
            float wi[4];
#pragma unroll
            for (int j = 0; j < 4; ++j) wi[j] = exn(m - Mt[j]);
#pragma unroll
            for (int i = 0; i < 5; ++i) { const int vt = 5 * cg5 + i; f32x4 acc = (f32x4){0.f, 0.f, 0.f, 0.f};
                acc = __builtin_amdgcn_mfma_f32_16x16x32_bf16(qa0, ldfrag(lds + CT, 16 * vt + fr, 0, fq), acc, 0, 0, 0);
                acc = __builtin_amdgcn_mfma_f32_16x16x32_bf16(qa1, ldfrag(lds + CT, 16 * vt + fr, 1, fq), acc, 0, 0, 0);
#pragma unroll
                for (int j = 0; j < 4; ++j) acc[j] *= wi[j];
                acc = __builtin_amdgcn_mfma_f32_16x16x32_bf16(pa0, ldfrag(lds + VT, 16 * vt + fr, 0, fq), acc, 0, 0, 0);
                acc = __builtin_amdgcn_mfma_f32_16x16x32_bf16(pa1, ldfrag(lds + VT, 16 * vt + fr, 1, fq), acc, 0, 0, 0);
                N[i] = acc; }
            if (cg5 == 1 && fr == 0) {
#pragma unroll
                for (int j = 0; j < 4; ++j) sden[16 * rb + 4 * fq + j] = N[3][j];
            }
        }
        __syncthreads();
        {
#pragma unroll
            for (int i = 0; i < 5; ++i) { const int vt = 5 * cg5 + i;
                u32x2 w; w.x = cvt_pk_bf16(C[i][0], C[i][1]); w.y = cvt_pk_bf16(C[i][2], C[i][3]);
                *(LAS u32x2*)(lds + CT + (16 * vt + fr) * P + (16 * rb + 4 * fq) * 2) = w; }
            float inv[4];
#pragma unroll
            for (int j = 0; j < 4; ++j) { const int t = 16 * rb + 4 * fq + j; const float dn = __builtin_fmaxf(__builtin_fabsf(sden[t]), expf(-(bt[j] + Mt[j]))); inv[j] = 1.0f / dn; }
#pragma unroll
            for (int i = 0; i < 5; ++i) { const int vt = 5 * cg5 + i;
                if (vt < 8) {
#pragma unroll
                    for (int j = 0; j < 4; ++j) { const int t = 16 * rb + 4 * fq + j; const int sgl = dir ? (SEQ - 1 - (64 * c + t)) : (64 * c + t);
                        const unsigned w = cvt_pk_bf16(N[i][j] * inv[j], 0.f);
                        hbuf[((size_t)dir * MTOK + (size_t)b * SEQ + sgl) * 512 + h * 128 + 16 * vt + fr] = (bf16_t)(w & 0xffffu); }
                }
            }
            m = bl + M63;
        }
    }
#undef MLS_LOAD
    __syncthreads();
}
}

#define XB_TMO      128
#define XB_XCNT(j)  (256  + 64 * (j))
#define XB_XSUB(j)  (1280 + 64 * (j))
#define XB_XGEN(j)  (2304 + 64 * (j))
#define XB_TOP      3328
#define XB_TOPGEN   3392
#define XCD_BAR_WORDS 3456
#define XB_SPIN_CAP (1u << 18)

__device__ __forceinline__ unsigned xb_ld(unsigned* p)              { return __hip_atomic_load(p, __ATOMIC_RELAXED, __HIP_MEMORY_SCOPE_AGENT); }
__device__ __forceinline__ unsigned xb_add(unsigned* p, unsigned v) { return __hip_atomic_fetch_add(p, v, __ATOMIC_RELAXED, __HIP_MEMORY_SCOPE_AGENT); }
__device__ __forceinline__ unsigned xb_xcc_id() { return (unsigned)__builtin_amdgcn_s_getreg((3 << 11) | 20) & 0xFu; }
#define XB_SPIN(cond, bar) do { unsigned _sp = 0; while (cond) { __builtin_amdgcn_s_sleep(1); \
    if ((++_sp & 255u) == 0u) { if (xb_ld(&(bar)[XB_TMO])) break; if (_sp > XB_SPIN_CAP) { atomicAdd(&(bar)[XB_TMO], 1u); break; } } } } while (0)

struct XcdBarrier {
    unsigned* bar; unsigned x;
    volatile LAS unsigned* st;
};

__device__ __forceinline__ XcdBarrier xcd_barrier_post(unsigned* bar, volatile LAS unsigned* st) {
    XcdBarrier b; b.bar = bar; b.x = xb_xcc_id(); b.st = st;
    if (threadIdx.x == 0) (void)xb_add(&bar[XB_XCNT(b.x)], 1u);
    return b;
}
__device__ __forceinline__ void xcd_barrier_complete(unsigned* bar, unsigned x, unsigned& nloc, unsigned& nx) {
    const unsigned G = gridDim.x * gridDim.y * gridDim.z;
    unsigned sum, cnt, mine, sp = 0u;
    for (;;) {
        sum = 0u; cnt = 0u; mine = 0u;
#pragma unroll
        for (unsigned j = 0; j < 16; ++j) { const unsigned c = xb_ld(&bar[XB_XCNT(j)]); sum += c; cnt += (c > 0u) ? 1u : 0u; mine = (j == x) ? c : mine; }
        if (sum == G) break;
        __builtin_amdgcn_s_sleep(1);
        if ((++sp & 255u) == 0u) { if (xb_ld(&bar[XB_TMO])) break; if (sp > XB_SPIN_CAP) { atomicAdd(&bar[XB_TMO], 1u); break; } }
    }
    nloc = mine > 0u ? mine : 1u; nx = cnt > 0u ? cnt : 1u;
}

__device__ __forceinline__ void xcd_barrier(const XcdBarrier& b) {
    asm volatile("s_waitcnt vmcnt(0)" ::: "memory");
    __syncthreads();
    if (threadIdx.x == 0) {
        unsigned* bar = b.bar;
        __builtin_amdgcn_s_waitcnt(0);
        unsigned nloc = b.st[0], nx = b.st[1];
        if (nloc == 0u) { xcd_barrier_complete(bar, b.x, nloc, nx); b.st[0] = nloc; b.st[1] = nx; }
        const unsigned old = xb_add(&bar[XB_XSUB(b.x)], 1u);
        const unsigned gen = old / nloc;
        if (old + 1u == (gen + 1u) * nloc) {
            __builtin_amdgcn_fence(__ATOMIC_RELEASE, "agent");
            asm volatile("s_waitcnt vmcnt(0)" ::: "memory");
            const unsigned og = xb_add(&bar[XB_TOP], 1u);
            const unsigned tg = og / nx;
            if (og + 1u == (tg + 1u) * nx) xb_add(&bar[XB_TOPGEN], 1u);
            else XB_SPIN(xb_ld(&bar[XB_TOPGEN]) == tg, bar);
            __builtin_amdgcn_fence(__ATOMIC_ACQUIRE, "agent");
            xb_add(&bar[XB_XGEN(b.x)], 1u);
            asm volatile("s_waitcnt vmcnt(0)" ::: "memory");
        } else {
            XB_SPIN(xb_ld(&bar[XB_XGEN(b.x)]) == gen, bar);
            __builtin_amdgcn_fence(__ATOMIC_ACQUIRE, "agent");
            asm volatile("s_waitcnt vmcnt(0)" ::: "memory");
        }
    }
    __syncthreads();
}

constexpr int NPH = 12;
#ifndef MK_REPEAT_MASK
#define MK_REPEAT_MASK 0
#endif
#define REPS(k) (1 + ((MK_REPEAT_MASK >> (k)) & 1))
__global__ void __launch_bounds__(512, 2) fwd_megakernel(Args args) {
    extern __shared__ __attribute__((aligned(16))) unsigned char lds_raw[];
    LAS unsigned char* lds = (LAS unsigned char*)lds_raw;
    cg::grid_group grid = cg::this_grid();
    const int tid = threadIdx.x, lane = tid & 63; const int wave = __builtin_amdgcn_readfirstlane(tid >> 6);
    const int G = gridDim.x, bx = blockIdx.x;
    const int gw = bx * 8 + wave, NGW = G * 8;
    unsigned char* ws = args.ws;
    float* ssq = (float*)(ws + WS_CTL + CTL_SSQ);
    unsigned* ctl = (unsigned*)(ws + WS_CTL);
    bf16_t* HG = (bf16_t*)(ws + WS_HG); bf16_t* ACT = (bf16_t*)(ws + WS_ACT); bf16_t* ZB = (bf16_t*)(ws + WS_ACT); bf16_t* VTG = (bf16_t*)(ws + WS_VT); bf16_t* KTG = (bf16_t*)(ws + WS_KT);
    float* GATES = (float*)(ws + WS_GATES); bf16_t* HBUF = (bf16_t*)(ws + WS_HBUF); bf16_t* MIX = (bf16_t*)(ws + WS_MIX); bf16_t* PB = (bf16_t*)(ws + WS_PB);
    float* out = args.out;
    const int lo = args.ph_lo, hi = args.ph_hi;
    if (tid < 64) ((LAS unsigned*)(lds + LDS_CTLW))[tid] = 0u;
    __syncthreads();
    XcdBarrier bar; bar.bar = ctl + CW_BAR; bar.x = 0; bar.st = nullptr;
    if (hi - lo > 1) bar = xcd_barrier_post(ctl + CW_BAR, (volatile LAS unsigned*)(lds + LDS_CTLW + 64));
    if (hi > 1000) grid.sync();
#define IN(k) (lo <= (k) && (k) < hi)
#define SEAM(k) do { if (IN(k) && IN((k) + 1)) xcd_barrier(bar); } while (0)

    if (IN(0)) { p0_prologue(args, lds, gw, NGW, wave, lane); }
    SEAM(0);
    if (IN(1)) for (int rep = 0; rep < REPS(1); ++rep) {
        if (rep) xcd_barrier(bar);
        pg8::Gemm g{HG, (const bf16_t*)(ws + WS_W1A), MTOK, 2 * DFF, DM}; pg8::StaticOrder S; S.init(MTOK, 2 * DFF, G, bx);
        pg8::EpiAct<0> E{ACT, DFF, ssq};
        pg8::gemm_phase<pg8::EpiAct<0>, pg8::StaticOrder, true, true>(lds, g, S, E);
    }
    SEAM(1);
    if (IN(2)) {
        pg8::Gemm g{ACT, (const bf16_t*)(ws + WS_W2A), MTOK, DM, DFF}; pg8::StaticOrder S; S.init(MTOK, DM, G, bx);
        pg8::EpiRes<0> E{args.in[0], out, 0.5f, HG, args.in[5], ssq + MTOK, nullptr};
        pg8::gemm_phase<pg8::EpiRes<0>, pg8::StaticOrder, true, true>(lds, g, S, E);
    }
    SEAM(2);
    if (IN(3)) for (int rep = 0; rep < REPS(3); ++rep) {
        if (rep) xcd_barrier(bar);
        {
            const bf16_t* WgT = (const bf16_t*)(ws + WS_WIN) + (size_t)3072 * DM; const float* ssq1 = ssq + MTOK; const float* bg = args.in[7];
            const int fr = lane & 15, fq = lane >> 4;
            for (int rbk = gw; rbk < MTOK / 16; rbk += NGW) {
                const bf16_t* ap = HG + (size_t)(rbk * 16 + fr) * DM + 8 * fq; const bf16_t* bp = WgT + (size_t)fr * DM + 8 * fq;
                f32x4 acc = (f32x4){0.f, 0.f, 0.f, 0.f};
#pragma unroll 8
                for (int ks = 0; ks < 32; ++ks) acc = __builtin_amdgcn_mfma_f32_16x16x32_bf16(*(const bf16x8*)(ap + 32 * ks), *(const bf16x8*)(bp + 32 * ks), acc, 0, 0, 0);
                const float bias = bg[fr];
#pragma unroll
                for (int j = 0; j < 4; ++j) { const int row = rbk * 16 + 4 * fq + j; const float rs = 1.0f / __builtin_sqrtf(ssq1[row] * (1.0f / DM) + EPS); GATES[(size_t)row * 16 + fr] = acc[j] * rs + bias; }
            }
        }
        pg8::Gemm g{HG, (const bf16_t*)(ws + WS_WIN), MTOK, 3072, DM}; pg8::StaticOrder S; S.init(MTOK, 3072, G, bx);
        pg8::EpiZ E{ZB, KTG, VTG, ssq + MTOK};
        pg8::gemm_phase<pg8::EpiZ, pg8::StaticOrder, true, true>(lds, g, S, E);
    }
    SEAM(3);
    if (IN(4)) for (int rep = 0; rep < REPS(4); ++rep) {
        if (rep) xcd_barrier(bar);
        volatile LAS unsigned* cw = (volatile LAS unsigned*)(lds + LDS_CTLW);
        for (int ch = bx; ch < 128; ch += G) mls::chain(lds, ZB, GATES, args.in[8], HBUF, ch);
        const float d1 = wave_sum(args.in[10][lane] * args.in[11][lane]), d2 = wave_sum(args.in[12][lane] * args.in[13][lane]);
        const float lam_init = 0.2f; const float lam = expf(d1) - expf(d2) + lam_init;
        const int q0 = (int)(xb_xcc_id() & 7u);
        for (int qi = 0; qi < 8; ++qi) {
            const int qq = (q0 + qi) & 7;
            for (;;) {
                if (tid == 0) cw[0] = atomicAdd(ctl + 64 * (1 + qq) + 16 * rep, 1u);
                __syncthreads();
                const unsigned li = cw[0];
                __syncthreads();
                if (li >= 128u) break;
                att::attn_unit(lds, ZB, KTG, VTG, MIX, args.in[14], 128 * qq + (int)li, lam, 1.0f - lam_init);
            }
        }
    }
    SEAM(4);
    if (IN(5)) {
        const float* gm = args.in[9];
        f32x4 g0 = *(const f32x4*)(gm + 8 * lane), g1 = *(const f32x4*)(gm + 8 * lane + 4);
        for (int row = gw; row < MTOK; row += NGW) {
            const u32x4 a = *(const u32x4*)(HBUF + (size_t)row * 512 + 8 * lane), bq = *(const u32x4*)(HBUF + ((size_t)MTOK + row) * 512 + 8 * lane);
            const u32x4 o = *(const u32x4*)(ZB + (size_t)row * ZLD + 1024 + 8 * lane);
            float v[8]; float s = 0.f;
#pragma unroll
            for (int e = 0; e < 4; ++e) { v[2 * e] = bf_lo(a[e]) + bf_lo(bq[e]); v[2 * e + 1] = bf_hi(a[e]) + bf_hi(bq[e]); s += v[2 * e] * v[2 * e] + v[2 * e + 1] * v[2 * e + 1]; }
            s += __shfl_xor(s, 1); s += __shfl_xor(s, 2); s += __shfl_xor(s, 4); s += __shfl_xor(s, 8);
            const float rn = 1.0f / __builtin_sqrtf(s * (1.0f / 128.0f) + EPS);
            float y[8]; const float gg[8] = {g0[0], g0[1], g0[2], g0[3], g1[0], g1[1], g1[2], g1[3]};
#pragma unroll
            for (int e = 0; e < 4; ++e) { y[2 * e] = pg8::sigmoid_f(bf_lo(o[e])) * v[2 * e] * rn * gg[2 * e]; y[2 * e + 1] = pg8::sigmoid_f(bf_hi(o[e])) * v[2 * e + 1] * rn * gg[2 * e + 1]; }
            u32x4 w; w.x = cvt_pk_bf16(y[0], y[1]); w.y = cvt_pk_bf16(y[2], y[3]); w.z = cvt_pk_bf16(y[4], y[5]); w.w = cvt_pk_bf16(y[6], y[7]);
            *(u32x4*)(MIX + (size_t)row * DM + 8 * lane) = w;
        }
    }
    SEAM(5);
    if (IN(6)) {
        pg8::Gemm g{MIX, (const bf16_t*)(ws + WS_WOUT), MTOK, DM, DM}; pg8::StaticOrder S; S.init(MTOK, DM, G, bx);
        pg8::EpiRes<0> E{out, out, 1.0f, HG, args.in[16], ssq + 2 * MTOK, nullptr};
        pg8::gemm_phase<pg8::EpiRes<0>, pg8::StaticOrder, true, true>(lds, g, S, E);
    }
    SEAM(6);
    if (IN(7)) {
        pg8::Gemm g{HG, (const bf16_t*)(ws + WS_W1B), MTOK, 2 * DFF, DM}; pg8::StaticOrder S; S.init(MTOK, 2 * DFF, G, bx);
        pg8::EpiAct<0> E{ACT, DFF, ssq + 2 * MTOK};
        pg8::gemm_phase<pg8::EpiAct<0>, pg8::StaticOrder, true, true>(lds, g, S, E);
    }
    SEAM(7);
    if (IN(8)) {
        pg8::Gemm g{ACT, (const bf16_t*)(ws + WS_W2B), MTOK, DM, DFF}; pg8::StaticOrder S; S.init(MTOK, DM, G, bx);
        pg8::EpiRes<0> E{out, out, 0.5f, HG, args.in[19], ssq + 3 * MTOK, nullptr};
        pg8::gemm_phase<pg8::EpiRes<0>, pg8::StaticOrder, true, true>(lds, g, S, E);
    }
    SEAM(8);
    if (IN(9)) for (int rep = 0; rep < REPS(9); ++rep) {   if (rep) xcd_barrier(bar);
        pg8::Gemm g{HG, (const bf16_t*)(ws + WS_WG), MTOK, DM, DM}; pg8::StaticOrder S; S.init(MTOK, DM, G, bx);
        pg8::EpiAct<1> E{MIX, DM, ssq + 3 * MTOK};
        pg8::gemm_phase<pg8::EpiAct<1>, pg8::StaticOrder, true, true>(lds, g, S, E);
    }
    if (IN(10)) {
        int kple = PLE; asm volatile("" : "+s"(kple));
        pg8::Gemm g{PB, (const bf16_t*)(ws + WS_WP), MTOK, DM, kple}; pg8::StaticOrder S; S.init(MTOK, DM, G, bx);
        pg8::EpiRes<1> E{out, out, 1.0f, nullptr, nullptr, ssq + 4 * MTOK, MIX};
        pg8::gemm_phase<pg8::EpiRes<1>, pg8::StaticOrder, true, true>(lds, g, S, E);
    }
    SEAM(10);
    if (IN(11)) {
        const float* gf = args.in[22];
        f32x4 gv[4];
#pragma unroll
        for (int j = 0; j < 4; ++j) gv[j] = *((const f32x4*)gf + lane + 64 * j);
        for (int row = gw; row < MTOK; row += NGW) {
            f32x4* xr = (f32x4*)(out + (size_t)row * DM) + lane; f32x4 v[4]; float s = 0.f;
#pragma unroll
            for (int j = 0; j < 4; ++j) { v[j] = xr[64 * j]; s += (v[j][0] * v[j][0] + v[j][1] * v[j][1]) + (v[j][2] * v[j][2] + v[j][3] * v[j][3]); }
            s = wave_sum(s);
            const float rs = 1.0f / __builtin_sqrtf(s * (1.0f / DM) + EPS);
#pragma unroll
            for (int j = 0; j < 4; ++j) xr[64 * j] = v[j] * rs * gv[j];
        }
    }
#undef IN
#undef SEAM
}

#ifndef MK_SPLIT
#define MK_SPLIT 0
#endif
extern "C" void kernel_launch(void* const* d_in, const int* in_sizes, int n_in, void* d_out, int out_size, void* d_ws, size_t ws_size, hipStream_t stream) {
    static int grid = 0;
    if (grid == 0) {
        if (n_in != 23 || in_sizes[0] != MTOK * DM || out_size != MTOK * DM || ws_size < WS_END) {
            fprintf(stderr, "kernel_launch: unexpected shapes (n_in %d, in0 %d, out %d, ws %zu); nothing launched\n", n_in, n_in > 0 ? in_sizes[0] : -1, out_size, ws_size); grid = -1; return; }
        int dev = 0, cus = 0, per_cu = 0;
        hipGetDevice(&dev); hipDeviceGetAttribute(&cus, hipDeviceAttributeMultiprocessorCount, dev);
        hipFuncSetAttribute((const void*)fwd_megakernel, hipFuncAttributeMaxDynamicSharedMemorySize, LDS_BYTES);
        hipOccupancyMaxActiveBlocksPerMultiprocessor(&per_cu, (const void*)fwd_megakernel, 512, LDS_BYTES);
        (void)hipGetLastError();
        if (per_cu < 1) fprintf(stderr, "kernel_launch: occupancy query says %d blocks/CU\n", per_cu);
        grid = cus > 0 ? cus : 256;
    }
    if (grid < 0) return;
    hipMemsetAsync((char*)d_ws + WS_CTL, 0, CTL_ZERO_BYTES, stream);
    Args a{};
    for (int i = 0; i < 23; ++i) a.in[i] = (const float*)d_in[i];
    a.out = (float*)d_out; a.ws = (unsigned char*)d_ws;
#if MK_SPLIT
    for (int ph = 0; ph < NPH; ++ph) { a.ph_lo = ph; a.ph_hi = ph + 1; hipLaunchKernelGGL(fwd_megakernel, dim3(grid), dim3(512), LDS_BYTES, stream, a); }
#else
    a.ph_lo = 0; a.ph_hi = NPH;
    void* kargs[] = {&a};
    hipError_t e = hipLaunchCooperativeKernel((const void*)fwd_megakernel, dim3(grid), dim3(512), kargs, LDS_BYTES, stream);
    if (e != hipSuccess) fprintf(stderr, "cooperative launch failed: %s (grid %d)\n", hipGetErrorString(e), grid);
#endif
}
```

```cpp
#include <hip/hip_runtime.h>
#include <hip/hip_cooperative_groups.h>
#include <cstdio>
#include <cstdint>
namespace cg = cooperative_groups;

constexpr int BATCH = 16, SEQ = 2048, DM = 1024, MTOK = BATCH * SEQ, DFF = 2816, DIN = 3088, DINP = 3328, ZLD = 2048, PLE = 256;
constexpr float EPS = 1e-6f;
constexpr float LOG2E = 1.4426950408889634f;

namespace pg8 {
#define PG8_LAS __attribute__((address_space(3)))
typedef unsigned short bf16_t;
typedef short bf16x8 __attribute__((ext_vector_type(8)));
typedef float f32x4 __attribute__((ext_vector_type(4)));
typedef unsigned u32x4 __attribute__((ext_vector_type(4)));
typedef unsigned u32x2 __attribute__((ext_vector_type(2)));
constexpr int BM = 256, BK = 64, HALF = 128, HTB = HALF * BK * 2  , STAGE_BYTES = 8 * HTB, NXCD = 8, WGM = 8;

__host__ __device__ __forceinline__ int lds_byte(int r, int c) { const int st = (r >> 4) * 2 + (c >> 5), rr = r & 15, cc = c & 31, ob = rr * 64 + cc * 2; return st * 1024 + (ob ^ (((ob >> 9) & 1) << 5)); }
__host__ __device__ __forceinline__ void stage_rc(int b, int& R, int& C) { const int st = b / 1024, sb = b % 1024, swz = sb ^ (((sb >> 9) & 1) << 5); R = (st >> 1) * 16 + swz / 64; C = (st & 1) * 32 + (swz % 64) / 2; }
__host__ __device__ __forceinline__ int perm32(int rho) { const int n = rho >> 4, i = rho & 15; return 8 * (i >> 2) + 4 * n + (i & 3); }

struct Unit { int pm, pn; };
struct Gemm { const bf16_t* A; const bf16_t* Bt; int M, N, K; };

struct StaticOrder {
    int nM, nN, nwg, G, c;
    __host__ __device__ void init(int M, int N, int G_, int c_) { nM = M / BM; nN = N / BM; nwg = nM * nN; G = G_; c = c_; }
    __host__ __device__ bool next(int i, Unit& u) const {
        const long L = (long)i * G + c; if (L >= nwg) return false;
        int wgid = (int)L; { const int q = nwg / NXCD, r = nwg % NXCD, xcd = wgid % NXCD, off = wgid / NXCD; wgid = (xcd < r ? xcd * (q + 1) : r * (q + 1) + (xcd - r) * q) + off; }
        const int nig = WGM * nN, gid = wgid / nig, fm = gid * WGM, gsz = (nM - fm) < WGM ? (nM - fm) : WGM;
        u.pm = fm + ((wgid % nig) % gsz); u.pn = (wgid % nig) / gsz; return true;
    }
    __device__ __forceinline__ void a_ready(const Unit&) const {}
    __device__ __forceinline__ void done(const Unit&) const {}
};

typedef float f32x2_t __attribute__((ext_vector_type(2))); typedef __bf16 bf16x2_t __attribute__((ext_vector_type(2)));
__device__ __forceinline__ unsigned cvt_pk_bf16(float lo, float hi) { f32x2_t v = {lo, hi}; bf16x2_t b = __builtin_convertvector(v, bf16x2_t); return __builtin_bit_cast(unsigned, b); }
__device__ __forceinline__ float fast_rcp(float x) { return __builtin_amdgcn_rcpf(x); }
__device__ __forceinline__ float sigmoid_f(float x) { return fast_rcp(1.0f + __builtin_amdgcn_exp2f(-x * LOG2E)); }


template <int MODE> struct EpiAct {
    static constexpr bool PERM = true, AFTER_DRAIN = false;
    bf16_t* O; int ldc; const float* ssq;
    __device__ __forceinline__ void operator()(const f32x4 (&acc)[2][2][4][2], const Unit& u, int wr, int wc, int fr, int fq) const {
        const int row0 = u.pm * BM + wr * 64 + fr;
#pragma unroll
        for (int ai = 0; ai < 2; ++ai)
#pragma unroll
            for (int m = 0; m < 4; ++m) {
                const int row = row0 + ai * HALF + m * 16;
                const float rs = __builtin_amdgcn_rsqf(ssq[row] * (1.0f / DM) + EPS);
                if (MODE == 0) {
                    u32x4 w; float o[8];
#pragma unroll
                    for (int n = 0; n < 2; ++n)
#pragma unroll
                        for (int j = 0; j < 4; ++j) { const float g = acc[ai][0][m][n][j] * rs, up = acc[ai][1][m][n][j] * rs; o[n * 4 + j] = g * sigmoid_f(g) * up; }
                    w.x = cvt_pk_bf16(o[0], o[1]); w.y = cvt_pk_bf16(o[2], o[3]); w.z = cvt_pk_bf16(o[4], o[5]); w.w = cvt_pk_bf16(o[6], o[7]);
                    *(u32x4*)(O + (size_t)row * ldc + u.pn * HALF + wc * 32 + 8 * fq) = w;
                } else {
#pragma unroll
                    for (int bj = 0; bj < 2; ++bj) {
                        u32x4 w; float o[8];
#pragma unroll
                        for (int n = 0; n < 2; ++n)
#pragma unroll
                            for (int j = 0; j < 4; ++j) o[n * 4 + j] = sigmoid_f(acc[ai][bj][m][n][j] * rs);
                        w.x = cvt_pk_bf16(o[0], o[1]); w.y = cvt_pk_bf16(o[2], o[3]); w.z = cvt_pk_bf16(o[4], o[5]); w.w = cvt_pk_bf16(o[6], o[7]);
                        *(u32x4*)(O + (size_t)row * ldc + u.pn * BM + bj * HALF + wc * 32 + 8 * fq) = w;
                    }
                }
            }
    }
};

struct EpiZ {
    static constexpr bool PERM = true, AFTER_DRAIN = false;
    bf16_t* zb; bf16_t* kt; bf16_t* vt; const float* ssq;
    __device__ __forceinline__ void operator()(const f32x4 (&acc)[2][2][4][2], const Unit& u, int wr, int wc, int fr, int fq) const {
        const int row0 = u.pm * BM + wr * 64 + fr;
#pragma unroll
        for (int ai = 0; ai < 2; ++ai)
#pragma unroll
            for (int m = 0; m < 4; ++m) {
                const int row = row0 + ai * HALF + m * 16;
                const float rs = __builtin_amdgcn_rsqf(ssq[row] * (1.0f / DM) + EPS);
                if (u.pn < 10) {
                    const int b = row >> 11, s = row & (SEQ - 1);
#pragma unroll
                    for (int bj = 0; bj < 2; ++bj) {
                        u32x4 w;
                        w.x = cvt_pk_bf16(acc[ai][bj][m][0][0] * rs, acc[ai][bj][m][0][1] * rs); w.y = cvt_pk_bf16(acc[ai][bj][m][0][2] * rs, acc[ai][bj][m][0][3] * rs);
                        w.z = cvt_pk_bf16(acc[ai][bj][m][1][0] * rs, acc[ai][bj][m][1][1] * rs); w.w = cvt_pk_bf16(acc[ai][bj][m][1][2] * rs, acc[ai][bj][m][1][3] * rs);
                        if (u.pn < 8) *(u32x4*)(zb + (size_t)row * ZLD + u.pn * BM + bj * HALF + wc * 32 + 8 * fq) = w;
                        else *(u32x4*)(kt + ((size_t)((b * 4 + 2 * (u.pn - 8) + bj) * 32 + (s >> 6)) * 64 + (s & 63)) * 128 + wc * 32 + 8 * fq) = w;
                    }
                } else if (u.pn < 12) {
                    const int b = row >> 11, s = row & (SEQ - 1);
#pragma unroll
                    for (int bj = 0; bj < 2; ++bj) {
                        const int hd = 2 * (u.pn - 10) + bj;
                        bf16_t* base = vt + ((size_t)((b * 4 + hd) * 32 + (s >> 6)) * 128 + wc * 32 + 8 * fq) * 64 + (s & 63);
#pragma unroll
                        for (int n = 0; n < 2; ++n) {
                            const unsigned w0 = cvt_pk_bf16(acc[ai][bj][m][n][0] * rs, acc[ai][bj][m][n][1] * rs), w1 = cvt_pk_bf16(acc[ai][bj][m][n][2] * rs, acc[ai][bj][m][n][3] * rs);
                            base[(4 * n + 0) * 64] = (bf16_t)(w0 & 0xffffu); base[(4 * n + 1) * 64] = (bf16_t)(w0 >> 16);
                            base[(4 * n + 2) * 64] = (bf16_t)(w1 & 0xffffu); base[(4 * n + 3) * 64] = (bf16_t)(w1 >> 16);
                        }
                    }
                }
            }
    }
};

template <int MODE> struct EpiRes {
    static constexpr bool PERM = false, AFTER_DRAIN = false;
    const float* base; float* out; float alpha; bf16_t* hg; const float* gain; float* ssq; const bf16_t* gate;
    __device__ __forceinline__ void operator()(const f32x4 (&acc)[2][2][4][2], const Unit& u, int wr, int wc, int fr, int fq) const {
        const int col0 = u.pn * BM + wc * 32 + 4 * fq;
#pragma unroll
        for (int ai = 0; ai < 2; ++ai)
#pragma unroll
            for (int m = 0; m < 4; ++m) {
                const int row = u.pm * BM + ai * HALF + wr * 64 + m * 16 + fr; const size_t off = (size_t)row * DM + col0;
                float ss = 0.f;
#pragma unroll
                for (int bj = 0; bj < 2; ++bj)
#pragma unroll
                    for (int n = 0; n < 2; ++n) {
                        const int co = bj * HALF + n * 16;
                        const f32x4 bs = *(const f32x4*)(base + off + co);
                        f32x4 h;
                        if (MODE == 0) h = bs + acc[ai][bj][m][n] * alpha;
                        else { const u32x2 gw = *(const u32x2*)(gate + off + co);
                               f32x4 gv; gv[0] = __uint_as_float(gw.x << 16); gv[1] = __uint_as_float(gw.x & 0xffff0000u); gv[2] = __uint_as_float(gw.y << 16); gv[3] = __uint_as_float(gw.y & 0xffff0000u);
                               h = bs + acc[ai][bj][m][n] * gv; }
                        *(f32x4*)(out + off + co) = h;
                        if (MODE == 0) ss += (h[0] * h[0] + h[1] * h[1]) + (h[2] * h[2] + h[3] * h[3]);
                        if (MODE == 0) { const f32x4 gn = *(const f32x4*)(gain + col0 + co); const f32x4 hv = h * gn;
                            u32x2 w; w.x = cvt_pk_bf16(hv[0], hv[1]); w.y = cvt_pk_bf16(hv[2], hv[3]); *(u32x2*)(hg + off + co) = w; }
                        if (MODE == 1) asm volatile("" ::: "memory");
                    }
                if (MODE == 0) { ss += __shfl_xor(ss, 16); ss += __shfl_xor(ss, 32);
                    if (fq == 0) atomicAdd(ssq + row, ss); }
                if (m & 1) asm volatile("" ::: "memory");
            }
    }
};

template <class Epi, class Sched, bool ALIGN_EPI = false, bool SP2 = false>
__device__ __forceinline__ void gemm_phase(PG8_LAS unsigned char* lds, const Gemm g, const Sched& S, const Epi& E) {
    const int tid = threadIdx.x, wid = __builtin_amdgcn_readfirstlane(tid >> 6), lane = tid & 63, wr = wid >> 2, wc = wid & 3, fr = lane & 15, fq = lane >> 4;
    const int K = g.K, nt = K / BK;
    unsigned voffA[2], voffB[2];
#pragma unroll
    for (int i = 0; i < 2; ++i) { int R, C; stage_rc(tid * 16 + i * 8192, R, C); const int Rb = Epi::PERM ? ((R & ~31) + perm32(R & 31)) : R;
        voffA[i] = (unsigned)(R * K + C) * 2u; voffB[i] = (unsigned)(Rb * K + C) * 2u; }
    const size_t kstep = (size_t)(BK * 2);
    const size_t hstep = (size_t)HALF * K * 2;
    const size_t tstep = 2 * hstep;
    const unsigned ldsw = (unsigned)wid * 1024u;
    const int aoff = lds_byte(wr * 64 + fr, fq * 8), boff = lds_byte(wc * 32 + fr, fq * 8);
#define PG8_SA(b, h) (((b) * 2 + (h)) * HTB)
#define PG8_SB(b, h) ((4 + (b) * 2 + (h)) * HTB)
#define PG8_STAGE(bufoff, gbase, voff) do { _Pragma("unroll") for (int _i = 0; _i < 2; ++_i) \
        __builtin_amdgcn_global_load_lds((const unsigned*)((const char*)(gbase) + (voff)[_i]), (PG8_LAS unsigned*)(lds + (bufoff) + ldsw + _i * 8192), 16, 0, 0); } while (0)
#define PG8_LDA(dst, b, h) do { _Pragma("unroll") for (int m = 0; m < 4; ++m) _Pragma("unroll") for (int k = 0; k < 2; ++k) dst[m][k] = *(const PG8_LAS bf16x8*)(lds + PG8_SA(b, h) + aoff + m * 2048 + k * 1024); } while (0)
#define PG8_LDB(dst, b, h) do { _Pragma("unroll") for (int n = 0; n < 2; ++n) _Pragma("unroll") for (int k = 0; k < 2; ++k) dst[n][k] = *(const PG8_LAS bf16x8*)(lds + PG8_SB(b, h) + boff + n * 2048 + k * 1024); } while (0)
#define PG8_MMA(ai, bj, At, Bt) do { __builtin_amdgcn_s_setprio(1); _Pragma("unroll") for (int m = 0; m < 4; ++m) _Pragma("unroll") for (int n = 0; n < 2; ++n) _Pragma("unroll") for (int k = 0; k < 2; ++k) \
        acc[ai][bj][m][n] = __builtin_amdgcn_mfma_f32_16x16x32_bf16(Bt[n][k], At[m][k], acc[ai][bj][m][n], 0, 0, 0); __builtin_amdgcn_s_setprio(0); } while (0)
#define PG8_WAIT_V(n) asm volatile("s_waitcnt vmcnt(" #n ")" ::: "memory")
#define PG8_WAIT_L(n) asm volatile("s_waitcnt lgkmcnt(" #n ")" ::: "memory")
#define PG8_BAR __builtin_amdgcn_s_barrier()
#define PG8_SCHED __builtin_amdgcn_sched_barrier(0)
    Unit cur, nxt; int ui = 0;
    if (!S.next(0, cur)) return;
    f32x4 acc[2][2][4][2];
#pragma unroll
    for (int a = 0; a < 2; ++a)
#pragma unroll
        for (int b = 0; b < 2; ++b)
#pragma unroll
            for (int m = 0; m < 4; ++m)
#pragma unroll
                for (int n = 0; n < 2; ++n) acc[a][b][m][n] = (f32x4){0.f, 0.f, 0.f, 0.f};
    bf16x8 At[4][2], B0[2][2], B1[2][2];
    const char* cA = (const char*)g.A + (size_t)cur.pm * tstep; const char* cB = (const char*)g.Bt + (size_t)cur.pn * tstep;
    S.a_ready(cur);
    if constexpr (SP2) {
        PG8_STAGE(PG8_SB(0, 0), cB, voffB); PG8_STAGE(PG8_SB(0, 1), cB + hstep, voffB); PG8_STAGE(PG8_SA(0, 0), cA, voffA); PG8_STAGE(PG8_SA(0, 1), cA + hstep, voffA);
        if (wr == 1) PG8_BAR;
        PG8_WAIT_V(2); PG8_BAR;
        PG8_STAGE(PG8_SB(1, 0), cB + kstep, voffB); PG8_STAGE(PG8_SA(1, 0), cA + kstep, voffA); PG8_STAGE(PG8_SB(1, 1), cB + hstep + kstep, voffB);
        PG8_WAIT_V(6); PG8_BAR;
    } else {
        PG8_STAGE(PG8_SB(0, 0), cB, voffB); PG8_STAGE(PG8_SA(0, 0), cA, voffA); PG8_STAGE(PG8_SB(0, 1), cB + hstep, voffB); PG8_STAGE(PG8_SA(0, 1), cA + hstep, voffA);
        if (wr == 1) PG8_BAR;
        PG8_WAIT_V(4); PG8_BAR;
        PG8_STAGE(PG8_SB(1, 0), cB + kstep, voffB); PG8_STAGE(PG8_SA(1, 0), cA + kstep, voffA); PG8_STAGE(PG8_SB(1, 1), cB + hstep + kstep, voffB);
        PG8_WAIT_V(6); PG8_BAR;
    }
    for (;;) {
        const bool has_next = S.next(ui + 1, nxt);
        const char* nA = has_next ? (const char*)g.A + (size_t)nxt.pm * tstep : cA; const char* nB = has_next ? (const char*)g.Bt + (size_t)nxt.pn * tstep : cB;
        for (int t = 0; t < nt; t += 2) {
            const bool last = (t == nt - 2);
            const char* a1 = cA + (size_t)(t + 1) * kstep;
            const char* a2 = last ? nA : cA + (size_t)(t + 2) * kstep; const char* b2 = last ? nB : cB + (size_t)(t + 2) * kstep;
            const char* a3 = a2 + kstep; const char* b3 = b2 + kstep;
            if (last && has_next) S.a_ready(nxt);
            if constexpr (SP2) {
            PG8_LDB(B0, 0, 0); PG8_LDB(B1, 0, 1); PG8_SCHED; PG8_LDA(At, 0, 0); PG8_STAGE(PG8_SA(1, 1), a1 + hstep, voffA);
            PG8_WAIT_V(8); PG8_WAIT_L(0); PG8_BAR; PG8_MMA(0, 0, At, B0); PG8_MMA(0, 1, At, B1); PG8_BAR; PG8_SCHED;
            PG8_LDA(At, 0, 1); PG8_STAGE(PG8_SB(0, 0), b2, voffB); PG8_STAGE(PG8_SB(0, 1), b2 + hstep, voffB); PG8_STAGE(PG8_SA(0, 0), a2, voffA);
            PG8_WAIT_V(8); PG8_WAIT_L(0); PG8_BAR; PG8_MMA(1, 0, At, B0); PG8_MMA(1, 1, At, B1); PG8_BAR; PG8_SCHED;
            PG8_LDB(B0, 1, 0); PG8_LDB(B1, 1, 1); PG8_SCHED; PG8_LDA(At, 1, 0); PG8_STAGE(PG8_SA(0, 1), a2 + hstep, voffA);
            PG8_WAIT_V(8); PG8_WAIT_L(0); PG8_BAR; PG8_MMA(0, 0, At, B0); PG8_MMA(0, 1, At, B1); PG8_BAR; PG8_SCHED;
            PG8_LDA(At, 1, 1); PG8_STAGE(PG8_SB(1, 0), b3, voffB); PG8_STAGE(PG8_SB(1, 1), b3 + hstep, voffB); PG8_STAGE(PG8_SA(1, 0), a3, voffA);
            PG8_WAIT_V(8); PG8_WAIT_L(0); PG8_BAR; PG8_MMA(1, 0, At, B0); PG8_MMA(1, 1, At, B1); PG8_BAR; PG8_SCHED;
            } else {
            PG8_LDB(B0, 0, 0); PG8_SCHED; PG8_LDA(At, 0, 0); PG8_STAGE(PG8_SA(1, 1), a1 + hstep, voffA);
            PG8_WAIT_L(8); PG8_BAR; PG8_WAIT_L(0); PG8_MMA(0, 0, At, B0); PG8_BAR; PG8_SCHED;
            PG8_LDB(B1, 0, 1); PG8_STAGE(PG8_SB(0, 0), b2, voffB);
            PG8_BAR; PG8_WAIT_L(0); PG8_MMA(0, 1, At, B1); PG8_BAR;
            PG8_LDA(At, 0, 1); PG8_STAGE(PG8_SA(0, 0), a2, voffA);
            PG8_BAR; PG8_WAIT_L(0); PG8_MMA(1, 0, At, B0); PG8_BAR; PG8_SCHED;
            PG8_STAGE(PG8_SB(0, 1), b2 + hstep, voffB);
            PG8_WAIT_V(6); PG8_BAR; PG8_MMA(1, 1, At, B1); PG8_BAR;
            PG8_LDB(B0, 1, 0); PG8_SCHED; PG8_LDA(At, 1, 0); PG8_STAGE(PG8_SA(0, 1), a2 + hstep, voffA);
            PG8_WAIT_L(8); PG8_BAR; PG8_WAIT_L(0); PG8_MMA(0, 0, At, B0); PG8_BAR; PG8_SCHED;
            PG8_LDB(B1, 1, 1); PG8_STAGE(PG8_SB(1, 0), b3, voffB);
            PG8_BAR; PG8_WAIT_L(0); PG8_MMA(0, 1, At, B1); PG8_BAR;
            PG8_LDA(At, 1, 1); PG8_STAGE(PG8_SA(1, 0), a3, voffA);
            PG8_BAR; PG8_WAIT_L(0); PG8_MMA(1, 0, At, B0); PG8_BAR; PG8_SCHED;
            PG8_STAGE(PG8_SB(1, 1), b3 + hstep, voffB);
            PG8_WAIT_V(6); PG8_BAR; PG8_MMA(1, 1, At, B1); PG8_BAR;
            }
        }
        if constexpr (ALIGN_EPI) { if (wr == 0) PG8_BAR; }
        if constexpr (!Epi::AFTER_DRAIN) { E(acc, cur, wr, wc, fr, fq); S.done(cur); }
        if (!has_next) break;
#pragma unroll
        for (int a = 0; a < 2; ++a)
#pragma unroll
            for (int b = 0; b < 2; ++b)
#pragma unroll
                for (int m = 0; m < 4; ++m)
#pragma unroll
                    for (int n = 0; n < 2; ++n) acc[a][b][m][n] = (f32x4){0.f, 0.f, 0.f, 0.f};
        cur = nxt; cA = nA; cB = nB; ++ui;
        if constexpr (ALIGN_EPI) { if (wr == 1) PG8_BAR; }
    }
    PG8_WAIT_V(0);
    if constexpr (!ALIGN_EPI) { if (wr == 0) PG8_BAR; }
    PG8_BAR;
    if constexpr (Epi::AFTER_DRAIN) { E.fused(acc, cur, wr, wc, fr, fq, lds, wid, lane); S.done(cur); }
#undef PG8_SA
#undef PG8_SB
#undef PG8_STAGE
#undef PG8_LDA
#undef PG8_LDB
#undef PG8_MMA
#undef PG8_WAIT_V
#undef PG8_WAIT_L
#undef PG8_BAR
#undef PG8_SCHED
}
}

#define LAS __attribute__((address_space(3)))
typedef unsigned short bf16_t;
typedef short bf16x8 __attribute__((ext_vector_type(8)));
typedef float f32x4 __attribute__((ext_vector_type(4)));
typedef float f32x16 __attribute__((ext_vector_type(16)));
typedef unsigned u32x4 __attribute__((ext_vector_type(4)));
typedef unsigned u32x2 __attribute__((ext_vector_type(2)));
using pg8::cvt_pk_bf16;
__device__ __forceinline__ float bf_lo(unsigned w) { return __uint_as_float(w << 16); }
__device__ __forceinline__ float bf_hi(unsigned w) { return __uint_as_float(w & 0xffff0000u); }
__device__ __forceinline__ float silu_f(float x) { return x * pg8::sigmoid_f(x); }
__device__ __forceinline__ float ex2(float x) { return __builtin_amdgcn_exp2f(x); }
__device__ __forceinline__ float exn(float x) { return __builtin_amdgcn_exp2f(x * LOG2E); }

constexpr size_t MiB = 1u << 20;
constexpr size_t WS_CTL = 0, CTL_ZERO_BYTES = 1 * MiB;
constexpr size_t CTL_SSQ = 64 * 1024;
constexpr int CW_BAR = 1024;
constexpr size_t WS_W1A = 2 * MiB, WS_W2A = 13 * MiB, WS_WIN = 19 * MiB, WS_WOUT = 26 * MiB, WS_W1B = 28 * MiB, WS_W2B = 39 * MiB, WS_WG = 45 * MiB, WS_WP = 47 * MiB;
constexpr size_t WS_HG = 64 * MiB;
constexpr size_t WS_ACT = 128 * MiB;
constexpr size_t WS_KT = 256 * MiB;
constexpr size_t WS_VT = 304 * MiB;
constexpr size_t WS_GATES = 336 * MiB;
constexpr size_t WS_HBUF = 338 * MiB;
constexpr size_t WS_MIX = 402 * MiB;
constexpr size_t WS_PB = 466 * MiB;
constexpr size_t WS_END = 482 * MiB;

constexpr int LDS_BYTES = 147456;
constexpr int LDS_CTLW = 143360;

__device__ __forceinline__ void transpose_item(const float* W, int K, int ldw, int k0, int nsrc0, int nvalid, bf16_t* WTrow0, LAS float* scr, int lane) {
#pragma unroll 8
    for (int i = 0; i < 32; ++i) { const int kk = 2 * i + (lane >> 5); const int c = lane & 31;
        scr[kk * 33 + c] = (c < nvalid) ? W[(size_t)(k0 + kk) * ldw + nsrc0 + c] : 0.f; }
    asm volatile("s_waitcnt lgkmcnt(0)" ::: "memory");
    const int c = lane & 7;
#pragma unroll
    for (int j = 0; j < 4; ++j) { const int n = (lane >> 3) + 8 * j; const LAS float* s = scr + (8 * c) * 33 + n;
        u32x4 o; o.x = cvt_pk_bf16(s[0 * 33], s[1 * 33]); o.y = cvt_pk_bf16(s[2 * 33], s[3 * 33]); o.z = cvt_pk_bf16(s[4 * 33], s[5 * 33]); o.w = cvt_pk_bf16(s[6 * 33], s[7 * 33]);
        *(u32x4*)(WTrow0 + (size_t)n * K + k0 + 8 * c) = o; }
    asm volatile("s_waitcnt lgkmcnt(0)" ::: "memory");
}
__device__ __forceinline__ float wave_sum(float v) {
#pragma unroll
    for (int o = 1; o < 64; o <<= 1) v += __shfl_xor(v, o);
    return v;
}

struct Args { const float* in[23]; float* out; unsigned char* ws; int ph_lo, ph_hi; };

constexpr int I_1 = 16 * 176, I_2 = 44 * 32, I_IN = 16 * 97, I_SQ = 16 * 32, I_P = 4 * 32;
__device__ __forceinline__ void conv_item(const Args& a, LAS float* scr, int lane, int kind, int f, int r) {
    unsigned char* ws = a.ws;
    if (kind == 0) {
        const int kb = r / 176, nb = r % 176, n0 = nb * 32;
        const int pn = n0 >> 8, rem = n0 & 255, half = rem >> 7, i = rem & 127;
        transpose_item(a.in[f ? 17 : 3], DM, 2 * DFF, kb * 64, half * DFF + 128 * pn + i, 32, (bf16_t*)(ws + (f ? WS_W1B : WS_W1A)) + (size_t)n0 * DM, scr, lane);
    } else if (kind == 1) {
        const int kb = r / 32, nb = r % 32;
        transpose_item(a.in[f ? 18 : 4], DFF, DM, kb * 64, nb * 32, 32, (bf16_t*)(ws + (f ? WS_W2B : WS_W2A)) + (size_t)(nb * 32) * DFF, scr, lane);
    } else if (kind == 2) {
        const int kb = r / 97, nb = r % 97, n0 = nb * 32; int ns, nv;
        if (n0 < 1536) { ns = n0; nv = 32; } else if (n0 < 3072) { ns = n0 + 16; nv = 32; } else { ns = 1536; nv = 16; }
        transpose_item(a.in[6], DM, DIN, kb * 64, ns, nv, (bf16_t*)(ws + WS_WIN) + (size_t)n0 * DM, scr, lane);
    } else if (kind == 3) {
        const int kb = r / 32, nb = r % 32;
        transpose_item(a.in[f ? 20 : 15], DM, DM, kb * 64, nb * 32, 32, (bf16_t*)(ws + (f ? WS_WG : WS_WOUT)) + (size_t)(nb * 32) * DM, scr, lane);
    } else {
        const int kb = r / 32, nb = r % 32;
        transpose_item(a.in[21], PLE, DM, kb * 64, nb * 32, 32, (bf16_t*)(ws + WS_WP) + (size_t)(nb * 32) * PLE, scr, lane);
    }
}
constexpr int LATE_W = I_1 + I_2 + 2 * I_SQ + I_P, LATE_N = LATE_W + MTOK / 64;
__device__ __forceinline__ void late_item(const Args& a, LAS float* scr, int lane, int it) {
    int r = it;
    if (r < I_1) { conv_item(a, scr, lane, 0, 1, r); return; } r -= I_1;
    if (r < I_2) { conv_item(a, scr, lane, 1, 1, r); return; } r -= I_2;
    if (r < I_SQ) { conv_item(a, scr, lane, 3, 0, r); return; } r -= I_SQ;
    if (r < I_SQ) { conv_item(a, scr, lane, 3, 1, r); return; } r -= I_SQ;
    if (r < I_P) { conv_item(a, scr, lane, 4, 0, r); return; } r -= I_P;
    const float* p = a.in[1]; bf16_t* pb = (bf16_t*)(a.ws + WS_PB);
    for (int m = r * 64; m < r * 64 + 64; ++m) { const f32x4 pv = *((const f32x4*)(p + (size_t)m * PLE) + lane);
        *((unsigned long long*)(pb + (size_t)m * PLE) + lane) = (unsigned long long)cvt_pk_bf16(pv[0], pv[1]) | ((unsigned long long)cvt_pk_bf16(pv[2], pv[3]) << 32); }
}

__device__ __forceinline__ void p0_prologue(const Args& a, LAS unsigned char* lds, int gw, int NGW, int wave, int lane) {
    LAS float* scr = (LAS float*)(lds + wave * 16384);
    unsigned char* ws = a.ws;
    constexpr int NITEMS = I_1 + I_2 + I_IN;
    for (int it = gw; it < NITEMS; it += NGW) {
        int r = it;
        if (r < I_1) { conv_item(a, scr, lane, 0, 0, r); continue; } r -= I_1;
        if (r < I_2) { conv_item(a, scr, lane, 1, 0, r); continue; } r -= I_2;
        conv_item(a, scr, lane, 2, 0, r);
    }
    const float* x = a.in[0]; const float* g1 = a.in[2];
    bf16_t* hg = (bf16_t*)(ws + WS_HG); float* ssq0 = (float*)(ws + WS_CTL + CTL_SSQ);
    f32x4 gv[4];
#pragma unroll
    for (int j = 0; j < 4; ++j) gv[j] = *((const f32x4*)g1 + lane + 64 * j);
    for (int m = gw; m < MTOK; m += NGW) {
        const f32x4* xr = (const f32x4*)(x + (size_t)m * DM) + lane; float s = 0.f;
        unsigned long long* o8 = (unsigned long long*)(hg + (size_t)m * DM) + lane;
#pragma unroll
        for (int j = 0; j < 4; ++j) { const f32x4 v = xr[64 * j]; s += (v[0] * v[0] + v[1] * v[1]) + (v[2] * v[2] + v[3] * v[3]); const f32x4 h = v * gv[j];
            o8[64 * j] = (unsigned long long)cvt_pk_bf16(h[0], h[1]) | ((unsigned long long)cvt_pk_bf16(h[2], h[3]) << 32); }
        s = wave_sum(s); if (lane == 0) ssq0[m] = s;
    }
}

namespace att {
constexpr int KP = 272, VP = 144, KTB = 64 * KP, VTB = 128 * VP;
constexpr int OFF_K = 0, OFF_V = 2 * KTB;
static_assert(OFF_V + 3 * VTB <= LDS_CTLW, "attention LDS");

__device__ __forceinline__ float a_add(float a, float b) { float r; asm volatile("v_add_f32_e32 %0, %1, %2" : "=v"(r) : "v"(a), "v"(b)); return r; }
__device__ __forceinline__ float a_add_s(float a, float sc) { float r; asm volatile("v_add_f32_e32 %0, %2, %1" : "=v"(r) : "v"(a), "s"(sc)); return r; }
__device__ __forceinline__ float a_fma(float a, float b, float c) { float r; asm volatile("v_fma_f32 %0, %1, %2, %3" : "=v"(r) : "v"(a), "v"(b), "v"(c)); return r; }
__device__ __forceinline__ float a_fma_abs(float a, float b, float c) { float r; asm volatile("v_fma_f32 %0, %1, |%2|, %3" : "=v"(r) : "v"(a), "v"(b), "v"(c)); return r; }
__device__ __forceinline__ float a_max3(float a, float b, float c) { float r; asm volatile("v_max3_f32 %0, %1, %2, %3" : "=v"(r) : "v"(a), "v"(b), "v"(c)); return r; }

#define SM_BIAS4(g)  asm volatile( \
        "v_add_f32_e32 %[t0], %[c0], %[dq]\n\tv_add_f32_e32 %[t1], %[c1], %[dq]\n\tv_add_f32_e32 %[t2], %[c2], %[dq]\n\tv_add_f32_e32 %[t3], %[c3], %[dq]\n\t" \
        "v_add_f32_e32 %[u0], %[c0], %[dr]\n\tv_add_f32_e32 %[u1], %[c1], %[dr]\n\tv_add_f32_e32 %[u2], %[c2], %[dr]\n\tv_add_f32_e32 %[u3], %[c3], %[dr]\n\t" \
        "v_fma_f32 %[a0], %[nk], |%[t0]|, %[a0]\n\tv_fma_f32 %[a1], %[nk], |%[t1]|, %[a1]\n\tv_fma_f32 %[a2], %[nk], |%[t2]|, %[a2]\n\tv_fma_f32 %[a3], %[nk], |%[t3]|, %[a3]\n\t" \
        "v_fma_f32 %[b0], %[nk], |%[u0]|, %[b0]\n\tv_fma_f32 %[b1], %[nk], |%[u1]|, %[b1]\n\tv_fma_f32 %[b2], %[nk], |%[u2]|, %[b2]\n\tv_fma_f32 %[b3], %[nk], |%[u3]|, %[b3]\n\t" \
        "v_max3_f32 %[ma], %[ma], %[a0], %[b0]\n\tv_max3_f32 %[mb], %[mb], %[a1], %[b1]\n\tv_max3_f32 %[ma], %[ma], %[a2], %[b2]\n\tv_max3_f32 %[mb], %[mb], %[a3], %[b3]" \
        : [a0] "+v"(s0[4 * g]), [a1] "+v"(s0[4 * g + 1]), [a2] "+v"(s0[4 * g + 2]), [a3] "+v"(s0[4 * g + 3]), \
          [b0] "+v"(s1[4 * g]), [b1] "+v"(s1[4 * g + 1]), [b2] "+v"(s1[4 * g + 2]), [b3] "+v"(s1[4 * g + 3]), [ma] "+v"(mxa), [mb] "+v"(mxb), \
          [t0] "=&v"(t0), [t1] "=&v"(t1), [t2] "=&v"(t2), [t3] "=&v"(t3), [u0] "=&v"(u0), [u1] "=&v"(u1), [u2] "=&v"(u2), [u3] "=&v"(u3) \
        : [dq] "v"(dq), [dr] "v"(dq32), [nk] "v"(nk2), [c0] "s"(8.0f * g), [c1] "s"(8.0f * g + 1.0f), [c2] "s"(8.0f * g + 2.0f), [c3] "s"(8.0f * g + 3.0f))
#define SM_FMA8(g)  asm volatile( \
        "v_fma_f32 %[a0], %[a0], %[cc], %[nb]\n\tv_fma_f32 %[a1], %[a1], %[cc], %[nb]\n\tv_fma_f32 %[a2], %[a2], %[cc], %[nb]\n\tv_fma_f32 %[a3], %[a3], %[cc], %[nb]\n\t" \
        "v_fma_f32 %[b0], %[b0], %[cc], %[nb]\n\tv_fma_f32 %[b1], %[b1], %[cc], %[nb]\n\tv_fma_f32 %[b2], %[b2], %[cc], %[nb]\n\tv_fma_f32 %[b3], %[b3], %[cc], %[nb]" \
        : [a0] "+v"(s0[4 * g]), [a1] "+v"(s0[4 * g + 1]), [a2] "+v"(s0[4 * g + 2]), [a3] "+v"(s0[4 * g + 3]), \
          [b0] "+v"(s1[4 * g]), [b1] "+v"(s1[4 * g + 1]), [b2] "+v"(s1[4 * g + 2]), [b3] "+v"(s1[4 * g + 3]) \
        : [cc] "v"(c1), [nb] "v"(nb))

__device__ __forceinline__ void softmax_tile(f32x16& s0, f32x16& s1, float& m, float& l, f32x16 (&O)[4], float dq, float c1, float nk2,
                                             bf16x8& p0, bf16x8& p1, bf16x8& p2, bf16x8& p3) {
    asm volatile("s_nop 15\n\ts_nop 7" : "+v"(s0), "+v"(s1));
    const float dq32 = dq + 32.0f;
    float mxa = -INFINITY, mxb = -INFINITY;
    { float t0, t1, t2, t3, u0, u1, u2, u3;
      SM_BIAS4(0); SM_BIAS4(1); SM_BIAS4(2); SM_BIAS4(3); }
    float mx = __builtin_fmaxf(mxa, mxb);
    mx = __builtin_fmaxf(mx, __shfl_xor(mx, 32));
    float alpha = 1.0f;
    const bool grow = __any(mx > m + 8.0f / c1);
    if (grow) { const float mn = __builtin_fmaxf(m, mx); alpha = ex2((m - mn) * c1); m = mn; }
    const float nb = -m * c1;
    SM_FMA8(0); SM_FMA8(1); SM_FMA8(2); SM_FMA8(3);
    float suma = 0.f, sumb = 0.f;
#pragma unroll
    for (int i = 0; i < 16; ++i) { s0[i] = ex2(s0[i]); s1[i] = ex2(s1[i]); suma += s0[i]; sumb += s1[i]; }
    l = l * alpha + (suma + sumb);
    if (grow) {
#pragma unroll
        for (int vt = 0; vt < 4; ++vt)
#pragma unroll
            for (int i = 0; i < 16; ++i) O[vt][i] *= alpha;
    }
    u32x4 w;
    w.x = cvt_pk_bf16(s0[0], s0[1]); w.y = cvt_pk_bf16(s0[2], s0[3]); w.z = cvt_pk_bf16(s0[4], s0[5]); w.w = cvt_pk_bf16(s0[6], s0[7]); p0 = __builtin_bit_cast(bf16x8, w);
    w.x = cvt_pk_bf16(s0[8], s0[9]); w.y = cvt_pk_bf16(s0[10], s0[11]); w.z = cvt_pk_bf16(s0[12], s0[13]); w.w = cvt_pk_bf16(s0[14], s0[15]); p1 = __builtin_bit_cast(bf16x8, w);
    w.x = cvt_pk_bf16(s1[0], s1[1]); w.y = cvt_pk_bf16(s1[2], s1[3]); w.z = cvt_pk_bf16(s1[4], s1[5]); w.w = cvt_pk_bf16(s1[6], s1[7]); p2 = __builtin_bit_cast(bf16x8, w);
    w.x = cvt_pk_bf16(s1[8], s1[9]); w.y = cvt_pk_bf16(s1[10], s1[11]); w.z = cvt_pk_bf16(s1[12], s1[13]); w.w = cvt_pk_bf16(s1[14], s1[15]); p3 = __builtin_bit_cast(bf16x8, w);
}

__device__ __forceinline__ void attn_unit(LAS unsigned char* lds, const bf16_t* zb, const bf16_t* ktg, const bf16_t* vtg, bf16_t* mix, const float* g_anorm, int unit, float lam, float onem) {
    const int tid = threadIdx.x, lane = tid & 63, r = lane & 31, hh = lane >> 5; const int wid = __builtin_amdgcn_readfirstlane(tid >> 6);
    const int map = wid >> 2, wq = wid & 3;
    const int bh = unit >> 4, qb = unit & 15, b = bh >> 2, h = bh & 3;
    const size_t tok0 = (size_t)b * SEQ;
    const bf16_t* kbase = ktg + (size_t)bh * 32 * 8192 + tid * 8;
    const bf16_t* qrow = zb + (tok0 + qb * 128 + 32 * wq + r) * ZLD + 1536 + h * 128 + map * 64 + 8 * hh;
    const bf16_t* vbase = vtg + (size_t)bh * 32 * 8192 + tid * 8;
    bf16x8 qf[4];
#pragma unroll
    for (int ks = 0; ks < 4; ++ks) qf[ks] = *(const bf16x8*)(qrow + 16 * ks);
    u32x4 kr[2], vr[2];
    const int krow0 = tid >> 4, kch = tid & 15, vrow0 = tid >> 3, vch = tid & 7;
#define ATT_LOAD(t) do { _Pragma("unroll") for (int i_ = 0; i_ < 2; ++i_) { \
        kr[i_] = *(const u32x4*)(kbase + (size_t)(t) * 8192 + 4096 * i_); \
        vr[i_] = *(const u32x4*)(vbase + (size_t)(t) * 8192 + 4096 * i_); } } while (0)
#define ATT_STORE(kbuf, vbuf) do { _Pragma("unroll") for (int i_ = 0; i_ < 2; ++i_) { \
        *(LAS u32x4*)(lds + OFF_K + (kbuf) * KTB + (krow0 + 32 * i_) * KP + kch * 16) = kr[i_]; \
        LAS unsigned char* vp_ = lds + OFF_V + (vbuf) * VTB + (vrow0 + 64 * i_) * VP + (vch >> 1) * 32 + (vch & 1) * 8; \
        *(LAS u32x2*)(vp_) = (u32x2){vr[i_].x, vr[i_].y}; *(LAS u32x2*)(vp_ + 16) = (u32x2){vr[i_].z, vr[i_].w}; } } while (0)
    ATT_LOAD(0); ATT_STORE(0, 0); ATT_LOAD(1);
    __syncthreads();
    const float slope = __builtin_amdgcn_exp2f(-2.0f * (float)(h + 1));
    const float c1 = 0.125f * LOG2E, nk2 = -8.0f * slope;
    const float qposf = (float)(qb * 128 + 32 * wq + r);
    f32x16 O[4];
#pragma unroll
    for (int vt = 0; vt < 4; ++vt) O[vt] = (f32x16){};
    float m = -INFINITY, l = 0.f;
    bf16x8 pa[4];
#define ATT_KRD(kf_) do { _Pragma("unroll") for (int i_ = 0; i_ < 8; ++i_) kf_[i_] = *(const LAS bf16x8*)(kp + (i_ >> 2) * 32 * KP + 32 * (i_ & 3)); } while (0)
#define ATT_QK(kf_) do { _Pragma("unroll") for (int ks_ = 0; ks_ < 4; ++ks_) { \
        s0 = __builtin_amdgcn_mfma_f32_32x32x16_bf16(kf_[ks_], qf[ks_], s0, 0, 0, 0); s1 = __builtin_amdgcn_mfma_f32_32x32x16_bf16(kf_[4 + ks_], qf[ks_], s1, 0, 0, 0); } } while (0)
#define ATT_PV(vslot) do { const LAS unsigned char* vp_ = lds + OFF_V + (vslot) * VTB + r * VP + 16 * hh; \
        _Pragma("unroll") for (int ks_ = 0; ks_ < 4; ++ks_) { bf16x8 vf_[4]; \
            _Pragma("unroll") for (int i_ = 0; i_ < 4; ++i_) vf_[i_] = *(const LAS bf16x8*)(vp_ + i_ * 32 * VP + ks_ * 32); \
            _Pragma("unroll") for (int i_ = 0; i_ < 4; ++i_) O[i_] = __builtin_amdgcn_mfma_f32_32x32x16_bf16(vf_[i_], pa[ks_], O[i_], 0, 0, 0); } } while (0)
#define ATT_STAGE(t_) do { const int vb_next_ = vb_cur == 2 ? 0 : vb_cur + 1; \
        if ((t_) + 1 < 32) ATT_STORE(((t_) + 1) & 1, vb_next_); if ((t_) + 2 < 32) ATT_LOAD((t_) + 2); vb_prev = vb_cur; vb_cur = vb_next_; } while (0)
    int vb_cur = 0, vb_prev = 2;
    if (map == 0) {
        for (int t = 0; t < 32; ++t) {
            const LAS unsigned char* kp = lds + OFF_K + (t & 1) * KTB + r * KP + 16 * hh;
            const float dq = (float)(t * 64 + 4 * hh) - qposf;
            f32x16 s0 = (f32x16){}, s1 = (f32x16){};
            { bf16x8 kf[8]; ATT_KRD(kf); ATT_QK(kf); }
            __builtin_amdgcn_sched_barrier(0);
            softmax_tile(s0, s1, m, l, O, dq, c1, nk2, pa[0], pa[1], pa[2], pa[3]);
            __builtin_amdgcn_sched_barrier(0);
            ATT_PV(vb_cur);
            ATT_STAGE(t);
            __syncthreads();
        }
    } else {
        for (int t = 0; t < 32; ++t) {
            const LAS unsigned char* kp = lds + OFF_K + (t & 1) * KTB + r * KP + 16 * hh + 128;
            const float dq = (float)(t * 64 + 4 * hh) - qposf;
            f32x16 s0 = (f32x16){}, s1 = (f32x16){};
            if (t > 0) ATT_PV(vb_prev);
            { bf16x8 kf[8]; ATT_KRD(kf); ATT_QK(kf); }
            __builtin_amdgcn_sched_barrier(0);
            softmax_tile(s0, s1, m, l, O, dq, c1, nk2, pa[0], pa[1], pa[2], pa[3]);
            __builtin_amdgcn_sched_barrier(0);
            ATT_STAGE(t);
            __syncthreads();
        }
        ATT_PV(vb_prev);
    }
    __syncthreads();
#undef ATT_STAGE
#undef ATT_KRD
#undef ATT_QK
#undef ATT_PV
#undef ATT_LOAD
#undef ATT_STORE
    l += __shfl_xor(l, 32);
    LAS float* xb = (LAS float*)(lds) + wq * 4096 + lane;
    if (map == 1) {
        const float sc = lam / l;
#pragma unroll
        for (int vt = 0; vt < 4; ++vt)
#pragma unroll
            for (int i = 0; i < 16; ++i) xb[(vt * 16 + i) * 64] = O[vt][i] * sc;
    }
    __syncthreads();
    if (map == 0) {
        const float inv1 = 1.0f / l;
        float ss = 0.f;
#pragma unroll
        for (int vt = 0; vt < 4; ++vt)
#pragma unroll
            for (int i = 0; i < 16; ++i) { const float o = O[vt][i] * inv1 - xb[(vt * 16 + i) * 64]; O[vt][i] = o; ss += o * o; }
        ss += __shfl_xor(ss, 32);
        const float rn = (1.0f / __builtin_sqrtf(ss * (1.0f / 128.0f) + EPS)) * onem;
        bf16_t* orow = mix + (tok0 + qb * 128 + 32 * wq + r) * DM + 512 + h * 128;
#pragma unroll
        for (int vt = 0; vt < 4; ++vt)
#pragma unroll
            for (int g4 = 0; g4 < 4; ++g4) { const int v0 = 32 * vt + 8 * g4 + 4 * hh; const f32x4 gn = *(const f32x4*)(g_anorm + h * 128 + v0);
                u32x2 w; w.x = cvt_pk_bf16(O[vt][4 * g4 + 0] * rn * gn[0], O[vt][4 * g4 + 1] * rn * gn[1]); w.y = cvt_pk_bf16(O[vt][4 * g4 + 2] * rn * gn[2], O[vt][4 * g4 + 3] * rn * gn[3]);
                *(u32x2*)(orow + v0) = w; }
    }
    __syncthreads();
}
}

namespace mls {
constexpr int P = 144;
constexpr int QS = 0, KS = 9216, KW = 18432, PS = 27648, VT = 36864, CT = 59904, SD = 82944, SCA = 83200, SCM = SCA + 8192, SCB = SCM + 8192, END = SCB + 8192;
static_assert(END <= LDS_CTLW, "mLSTM LDS");
__device__ __forceinline__ bf16x8 ldfrag(const LAS unsigned char* base, int row, int ks, int fq) { return *(const LAS bf16x8*)(base + row * P + ks * 64 + fq * 16); }

__device__ __forceinline__ void chain(LAS unsigned char* lds, const bf16_t* zb, const float* gates, const float* conv_w, bf16_t* hbuf, int chain_id) {
    const int tid = threadIdx.x, lane = tid & 63, fr = lane & 15, fq = lane >> 4; const int wid = __builtin_amdgcn_readfirstlane(tid >> 6);
    const int dir = chain_id & 1, bh = chain_id >> 1, b = bh >> 2, h = bh & 3;
    const int rb = wid & 3, cg5 = wid >> 2;
    LAS float* sden = (LAS float*)(lds + SD); LAS float* scA = (LAS float*)(lds + SCA); LAS float* scM = (LAS float*)(lds + SCM); LAS float* scB = (LAS float*)(lds + SCB);
    for (int i = tid; i < 160 * (P / 4); i += 512) ((LAS unsigned*)(lds + CT))[i] = 0u;
    for (int i = tid; i < 32 * (P / 4); i += 512) ((LAS unsigned*)(lds + VT + 128 * P))[i] = (i < (P / 4)) ? 0x3F803F80u : 0u;
    for (int cc = wid; cc < 32; cc += 8) {
        const int sl = dir ? (SEQ - 1 - (64 * cc + lane)) : (64 * cc + lane);
        const float* gr = gates + ((size_t)b * SEQ + sl) * 16 + (2 * dir) * 4 + h;
        const float gi = gr[0], gf = gr[4];
        const float lf = __builtin_fminf(gf, 0.f) - log1pf(expf(-__builtin_fabsf(gf)));
        float bs = lf;
#pragma unroll
        for (int o = 1; o < 64; o <<= 1) { const float t2 = __shfl_up(bs, o); if (lane >= o) bs += t2; }
        const float av = gi - bs; float am = av;
#pragma unroll
        for (int o = 1; o < 64; o <<= 1) { const float t2 = __shfl_up(am, o); if (lane >= o) am = __builtin_fmaxf(am, t2); }
        scA[cc * 64 + lane] = av; scM[cc * 64 + lane] = am; scB[cc * 64 + lane] = bs;
    }
    f32x4 C[5];
#pragma unroll
    for (int i = 0; i < 5; ++i) C[i] = (f32x4){0.f, 0.f, 0.f, 0.f};
    float m = 0.f;
    const int t_ld = tid >> 3, c8 = tid & 7;
    const u32x4 zero4 = (u32x4){0u, 0u, 0u, 0u};
    u32x4 q0, k0, qm, km, qp, kp, v0, v1;
#define MLS_LOAD(c_) do { const int sg_ = dir ? (SEQ - 1 - (64 * (c_) + t_ld)) : (64 * (c_) + t_ld); const bf16_t* zrow_ = zb + ((size_t)b * SEQ + sg_) * ZLD; \
        q0 = *(const u32x4*)(zrow_ + h * 64 + 8 * c8); k0 = *(const u32x4*)(zrow_ + 256 + h * 64 + 8 * c8); \
        qm = sg_ > 0 ? *(const u32x4*)(zrow_ - ZLD + h * 64 + 8 * c8) : zero4; km = sg_ > 0 ? *(const u32x4*)(zrow_ - ZLD + 256 + h * 64 + 8 * c8) : zero4; \
        qp = sg_ < SEQ - 1 ? *(const u32x4*)(zrow_ + ZLD + h * 64 + 8 * c8) : zero4; kp = sg_ < SEQ - 1 ? *(const u32x4*)(zrow_ + ZLD + 256 + h * 64 + 8 * c8) : zero4; \
        v0 = *(const u32x4*)(zrow_ + 512 + h * 128 + 16 * c8); v1 = *(const u32x4*)(zrow_ + 512 + h * 128 + 16 * c8 + 8); } while (0)
    MLS_LOAD(0);
    const float* cw = conv_w + h * 64 + 8 * c8;
    __syncthreads();
    for (int c = 0; c < 32; ++c) {
        const float M63 = __builtin_fmaxf(m, scM[c * 64 + 63]), bl = scB[c * 64 + 63];
        {
            const float wkt = exn(scA[c * 64 + t_ld] - M63);
            float qv[8], kv[8];
#pragma unroll
            for (int e4 = 0; e4 < 2; ++e4) {
                const f32x4 wq0 = *(const f32x4*)(cw + 4 * e4), wq1 = *(const f32x4*)(cw + 512 + 4 * e4), wq2 = *(const f32x4*)(cw + 1024 + 4 * e4);
                const f32x4 wk0 = *(const f32x4*)(cw + 256 + 4 * e4), wk1 = *(const f32x4*)(cw + 768 + 4 * e4), wk2 = *(const f32x4*)(cw + 1280 + 4 * e4);
#pragma unroll
                for (int e2 = 0; e2 < 2; ++e2) {
                    const int wi = 2 * e4 + e2;
                    const unsigned a_m = qm[wi], a_0 = q0[wi], a_p = qp[wi], b_m = km[wi], b_0 = k0[wi], b_p = kp[wi];
                    const float ql = wq0[2 * e2] * bf_lo(a_m) + wq1[2 * e2] * bf_lo(a_0) + wq2[2 * e2] * bf_lo(a_p);
                    const float qh = wq0[2 * e2 + 1] * bf_hi(a_m) + wq1[2 * e2 + 1] * bf_hi(a_0) + wq2[2 * e2 + 1] * bf_hi(a_p);
                    const float kl = wk0[2 * e2] * bf_lo(b_m) + wk1[2 * e2] * bf_lo(b_0) + wk2[2 * e2] * bf_lo(b_p);
                    const float kh = wk0[2 * e2 + 1] * bf_hi(b_m) + wk1[2 * e2 + 1] * bf_hi(b_0) + wk2[2 * e2 + 1] * bf_hi(b_p);
                    qv[2 * wi] = silu_f(ql); qv[2 * wi + 1] = silu_f(qh); kv[2 * wi] = silu_f(kl) * 0.125f; kv[2 * wi + 1] = silu_f(kh) * 0.125f;
                }
            }
            u32x4 w;
            w.x = cvt_pk_bf16(qv[0], qv[1]); w.y = cvt_pk_bf16(qv[2], qv[3]); w.z = cvt_pk_bf16(qv[4], qv[5]); w.w = cvt_pk_bf16(qv[6], qv[7]);
            *(LAS u32x4*)(lds + QS + t_ld * P + c8 * 16) = w;
            w.x = cvt_pk_bf16(kv[0], kv[1]); w.y = cvt_pk_bf16(kv[2], kv[3]); w.z = cvt_pk_bf16(kv[4], kv[5]); w.w = cvt_pk_bf16(kv[6], kv[7]);
            *(LAS u32x4*)(lds + KS + t_ld * P + c8 * 16) = w;
#pragma unroll
            for (int e = 0; e < 8; e += 2) { const unsigned pk = cvt_pk_bf16(kv[e] * wkt, kv[e + 1] * wkt);
                *(LAS bf16_t*)(lds + KW + (8 * c8 + e) * P + t_ld * 2) = (bf16_t)(pk & 0xffffu); *(LAS bf16_t*)(lds + KW + (8 * c8 + e + 1) * P + t_ld * 2) = (bf16_t)(pk >> 16); }
#pragma unroll
            for (int e = 0; e < 4; ++e) {
                *(LAS bf16_t*)(lds + VT + (16 * c8 + 2 * e) * P + t_ld * 2) = (bf16_t)(v0[e] & 0xffffu); *(LAS bf16_t*)(lds + VT + (16 * c8 + 2 * e + 1) * P + t_ld * 2) = (bf16_t)(v0[e] >> 16);
                *(LAS bf16_t*)(lds + VT + (16 * c8 + 8 + 2 * e) * P + t_ld * 2) = (bf16_t)(v1[e] & 0xffffu); *(LAS bf16_t*)(lds + VT + (16 * c8 + 8 + 2 * e + 1) * P + t_ld * 2) = (bf16_t)(v1[e] >> 16); }
        }
        if (c + 1 < 32) MLS_LOAD(c + 1);
        __syncthreads();
        const bf16x8 qa0 = ldfrag(lds + QS, 16 * rb + fr, 0, fq), qa1 = ldfrag(lds + QS, 16 * rb + fr, 1, fq);
        float Mt[4], bt[4];
#pragma unroll
        for (int j = 0; j < 4; ++j) { Mt[j] = __builtin_fmaxf(m, scM[c * 64 + 16 * rb + 4 * fq + j]); bt[j] = scB[c * 64 + 16 * rb + 4 * fq + j]; }
        {
#pragma unroll
            for (int si = 0; si < 2; ++si) { const int sbk = 2 * cg5 + si; f32x4 acc = (f32x4){0.f, 0.f, 0.f, 0.f};
                if (sbk <= rb) {
                    acc = __builtin_amdgcn_mfma_f32_16x16x32_bf16(qa0, ldfrag(lds + KS, 16 * sbk + fr, 0, fq), acc, 0, 0, 0);
                    acc = __builtin_amdgcn_mfma_f32_16x16x32_bf16(qa1, ldfrag(lds + KS, 16 * sbk + fr, 1, fq), acc, 0, 0, 0);
                    const int s = 16 * sbk + fr; const float as = scA[c * 64 + s];
#pragma unroll
                    for (int j = 0; j < 4; ++j) { const int t = 16 * rb + 4 * fq + j; acc[j] = (s <= t) ? acc[j] * exn(as - Mt[j]) : 0.f; }
                }
                const unsigned w0 = cvt_pk_bf16(acc[0], acc[1]), w1 = cvt_pk_bf16(acc[2], acc[3]);
                LAS unsigned char* pp = lds + PS + (16 * rb + 4 * fq) * P + (16 * sbk + fr) * 2;
                *(LAS bf16_t*)(pp) = (bf16_t)(w0 & 0xffffu); *(LAS bf16_t*)(pp + P) = (bf16_t)(w0 >> 16); *(LAS bf16_t*)(pp + 2 * P) = (bf16_t)(w1 & 0xffffu); *(LAS bf16_t*)(pp + 3 * P) = (bf16_t)(w1 >> 16);
            }
        }
        {
            const float decay = exn(m - M63);
            const bf16x8 ka0 = ldfrag(lds + KW, 16 * rb + fr, 0, fq), ka1 = ldfrag(lds + KW, 16 * rb + fr, 1, fq);
#pragma unroll
            for (int i = 0; i < 5; ++i) { const int vt = 5 * cg5 + i;
                C[i] = C[i] * decay;
                C[i] = __builtin_amdgcn_mfma_f32_16x16x32_bf16(ka0, ldfrag(lds + VT, 16 * vt + fr, 0, fq), C[i], 0, 0, 0);
                C[i] = __builtin_amdgcn_mfma_f32_16x16x32_bf16(ka1, ldfrag(lds + VT, 16 * vt + fr, 1, fq), C[i], 0, 0, 0); }
        }
        __syncthreads();
        f32x4 N[5];
        {
            const bf16x8 pa0 = ldfrag(lds + PS, 16 * rb + fr, 0, fq), pa1 = ldfrag(lds + PS, 16 * rb + fr, 1, fq);
            float wi[4];
#pragma unroll
            for (int j = 0; j < 4; ++j) wi[j] = exn(m - Mt[j]);
#pragma unroll
            for (int i = 0; i < 5; ++i) { const int vt = 5 * cg5 + i; f32x4 acc = (f32x4){0.f, 0.f, 0.f, 0.f};
                acc = __builtin_amdgcn_mfma_f32_16x16x32_bf16(qa0, ldfrag(lds + CT, 16 * vt + fr, 0, fq), acc, 0, 0, 0);
                acc = __builtin_amdgcn_mfma_f32_16x16x32_bf16(qa1, ldfrag(lds + CT, 16 * vt + fr, 1, fq), acc, 0, 0, 0);
#pragma unroll
                for (int j = 0; j < 4; ++j) acc[j] *= wi[j];
                acc = __builtin_amdgcn_mfma_f32_16x16x32_bf16(pa0, ldfrag(lds + VT, 16 * vt + fr, 0, fq), acc, 0, 0, 0);
                acc = __builtin_amdgcn_mfma_f32_16x16x32_bf16(pa1, ldfrag(lds + VT, 16 * vt + fr, 1, fq), acc, 0, 0, 0);
                N[i] = acc; }
            if (cg5 == 1 && fr == 0) {
#pragma unroll
                for (int j = 0; j < 4; ++j) sden[16 * rb + 4 * fq + j] = N[3][j];
            }
        }
        __syncthreads();
        {
#pragma unroll
            for (int i = 0; i < 5; ++i) { const int vt = 5 * cg5 + i;
                u32x2 w; w.x = cvt_pk_bf16(C[i][0], C[i][1]); w.y = cvt_pk_bf16(C[i][2], C[i][3]);
                *(LAS u32x2*)(lds + CT + (16 * vt + fr) * P + (16 * rb + 4 * fq) * 2) = w; }
            float inv[4];
#pragma unroll
            for (int j = 0; j < 4; ++j) { const int t = 16 * rb + 4 * fq + j; const float dn = __builtin_fmaxf(__builtin_fabsf(sden[t]), expf(-(bt[j] + Mt[j]))); inv[j] = 1.0f / dn; }
#pragma unroll
            for (int i = 0; i < 5; ++i) { const int vt = 5 * cg5 + i;
                if (vt < 8) {
#pragma unroll
                    for (int j = 0; j < 4; ++j) { const int t = 16 * rb + 4 * fq + j; const int sgl = dir ? (SEQ - 1 - (64 * c + t)) : (64 * c + t);
                        const unsigned w = cvt_pk_bf16(N[i][j] * inv[j], 0.f);
                        hbuf[((size_t)dir * MTOK + (size_t)b * SEQ + sgl) * 512 + h * 128 + 16 * vt + fr] = (bf16_t)(w & 0xffffu); }
                }
            }
            m = bl + M63;
        }
    }
#undef MLS_LOAD
    __syncthreads();
}
}

#define XB_TMO      128
#define XB_XCNT(j)  (256  + 64 * (j))
#define XB_XSUB(j)  (1280 + 64 * (j))
#define XB_XGEN(j)  (2304 + 64 * (j))
#define XB_TOP      3328
#define XB_TOPGEN   3392
#define XCD_BAR_WORDS 3456
#define XB_SPIN_CAP (1u << 18)

__device__ __forceinline__ unsigned xb_ld(unsigned* p)              { return __hip_atomic_load(p, __ATOMIC_RELAXED, __HIP_MEMORY_SCOPE_AGENT); }
__device__ __forceinline__ unsigned xb_add(unsigned* p, unsigned v) { return __hip_atomic_fetch_add(p, v, __ATOMIC_RELAXED, __HIP_MEMORY_SCOPE_AGENT); }
__device__ __forceinline__ unsigned xb_xcc_id() { return (unsigned)__builtin_amdgcn_s_getreg((3 << 11) | 20) & 0xFu; }
#define XB_SPIN(cond, bar) do { unsigned _sp = 0; while (cond) { __builtin_amdgcn_s_sleep(1); \
    if ((++_sp & 255u) == 0u) { if (xb_ld(&(bar)[XB_TMO])) break; if (_sp > XB_SPIN_CAP) { atomicAdd(&(bar)[XB_TMO], 1u); break; } } } } while (0)

struct XcdBarrier {
    unsigned* bar; unsigned x;
    volatile LAS unsigned* st;
};

__device__ __forceinline__ XcdBarrier xcd_barrier_post(unsigned* bar, volatile LAS unsigned* st) {
    XcdBarrier b; b.bar = bar; b.x = xb_xcc_id(); b.st = st;
    if (threadIdx.x == 0) (void)xb_add(&bar[XB_XCNT(b.x)], 1u);
    return b;
}
__device__ __forceinline__ void xcd_barrier_complete(unsigned* bar, unsigned x, unsigned& nloc, unsigned& nx) {
    const unsigned G = gridDim.x * gridDim.y * gridDim.z;
    unsigned sum, cnt, mine, sp = 0u;
    for (;;) {
        sum = 0u; cnt = 0u; mine = 0u;
#pragma unroll
        for (unsigned j = 0; j < 16; ++j) { const unsigned c = xb_ld(&bar[XB_XCNT(j)]); sum += c; cnt += (c > 0u) ? 1u : 0u; mine = (j == x) ? c : mine; }
        if (sum == G) break;
        __builtin_amdgcn_s_sleep(1);
        if ((++sp & 255u) == 0u) { if (xb_ld(&bar[XB_TMO])) break; if (sp > XB_SPIN_CAP) { atomicAdd(&bar[XB_TMO], 1u); break; } }
    }
    nloc = mine > 0u ? mine : 1u; nx = cnt > 0u ? cnt : 1u;
}

__device__ __forceinline__ void xcd_barrier(const XcdBarrier& b) {
    asm volatile("s_waitcnt vmcnt(0)" ::: "memory");
    __syncthreads();
    if (threadIdx.x == 0) {
        unsigned* bar = b.bar;
        __builtin_amdgcn_s_waitcnt(0);
        unsigned nloc = b.st[0], nx = b.st[1];
        if (nloc == 0u) { xcd_barrier_complete(bar, b.x, nloc, nx); b.st[0] = nloc; b.st[1] = nx; }
        const unsigned old = xb_add(&bar[XB_XSUB(b.x)], 1u);
        const unsigned gen = old / nloc;
        if (old + 1u == (gen + 1u) * nloc) {
            __builtin_amdgcn_fence(__ATOMIC_RELEASE, "agent");
            asm volatile("s_waitcnt vmcnt(0)" ::: "memory");
            const unsigned og = xb_add(&bar[XB_TOP], 1u);
            const unsigned tg = og / nx;
            if (og + 1u == (tg + 1u) * nx) xb_add(&bar[XB_TOPGEN], 1u);
            else XB_SPIN(xb_ld(&bar[XB_TOPGEN]) == tg, bar);
            __builtin_amdgcn_fence(__ATOMIC_ACQUIRE, "agent");
            xb_add(&bar[XB_XGEN(b.x)], 1u);
            asm volatile("s_waitcnt vmcnt(0)" ::: "memory");
        } else {
            XB_SPIN(xb_ld(&bar[XB_XGEN(b.x)]) == gen, bar);
            __builtin_amdgcn_fence(__ATOMIC_ACQUIRE, "agent");
            asm volatile("s_waitcnt vmcnt(0)" ::: "memory");
        }
    }
    __syncthreads();
}

constexpr int NPH = 12;
#ifndef MK_REPEAT_MASK
#define MK_REPEAT_MASK 0
#endif
#define REPS(k) (1 + ((MK_REPEAT_MASK >> (k)) & 1))
__global__ void __launch_bounds__(512, 2) fwd_megakernel(Args args) {
    extern __shared__ __attribute__((aligned(16))) unsigned char lds_raw[];
    LAS unsigned char* lds = (LAS unsigned char*)lds_raw;
    cg::grid_group grid = cg::this_grid();
    const int tid = threadIdx.x, lane = tid & 63; const int wave = __builtin_amdgcn_readfirstlane(tid >> 6);
    const int G = gridDim.x, bx = blockIdx.x;
    const int gw = bx * 8 + wave, NGW = G * 8;
    unsigned char* ws = args.ws;
    float* ssq = (float*)(ws + WS_CTL + CTL_SSQ);
    unsigned* ctl = (unsigned*)(ws + WS_CTL);
    bf16_t* HG = (bf16_t*)(ws + WS_HG); bf16_t* ACT = (bf16_t*)(ws + WS_ACT); bf16_t* ZB = (bf16_t*)(ws + WS_ACT); bf16_t* VTG = (bf16_t*)(ws + WS_VT); bf16_t* KTG = (bf16_t*)(ws + WS_KT);
    float* GATES = (float*)(ws + WS_GATES); bf16_t* HBUF = (bf16_t*)(ws + WS_HBUF); bf16_t* MIX = (bf16_t*)(ws + WS_MIX); bf16_t* PB = (bf16_t*)(ws + WS_PB);
    float* out = args.out;
    const int lo = args.ph_lo, hi = args.ph_hi;
    if (tid < 64) ((LAS unsigned*)(lds + LDS_CTLW))[tid] = 0u;
    __syncthreads();
    XcdBarrier bar; bar.bar = ctl + CW_BAR; bar.x = 0; bar.st = nullptr;
    if (hi - lo > 1) bar = xcd_barrier_post(ctl + CW_BAR, (volatile LAS unsigned*)(lds + LDS_CTLW + 64));
    if (hi > 1000) grid.sync();
#define IN(k) (lo <= (k) && (k) < hi)
#define SEAM(k) do { if (IN(k) && IN((k) + 1)) xcd_barrier(bar); } while (0)

    if (IN(0)) { p0_prologue(args, lds, gw, NGW, wave, lane); }
    SEAM(0);
    if (IN(1)) for (int rep = 0; rep < REPS(1); ++rep) {
        if (rep) xcd_barrier(bar);
        pg8::Gemm g{HG, (const bf16_t*)(ws + WS_W1A), MTOK, 2 * DFF, DM}; pg8::StaticOrder S; S.init(MTOK, 2 * DFF, G, bx);
        pg8::EpiAct<0> E{ACT, DFF, ssq};
        pg8::gemm_phase<pg8::EpiAct<0>, pg8::StaticOrder, true, true>(lds, g, S, E);
    }
    SEAM(1);
    if (IN(2)) {
        pg8::Gemm g{ACT, (const bf16_t*)(ws + WS_W2A), MTOK, DM, DFF}; pg8::StaticOrder S; S.init(MTOK, DM, G, bx);
        pg8::EpiRes<0> E{args.in[0], out, 0.5f, HG, args.in[5], ssq + MTOK, nullptr};
        pg8::gemm_phase<pg8::EpiRes<0>, pg8::StaticOrder, true, true>(lds, g, S, E);
    }
    SEAM(2);
    if (IN(3)) for (int rep = 0; rep < REPS(3); ++rep) {
        if (rep) xcd_barrier(bar);
        {
            const bf16_t* WgT = (const bf16_t*)(ws + WS_WIN) + (size_t)3072 * DM; const float* ssq1 = ssq + MTOK; const float* bg = args.in[7];
            const int fr = lane & 15, fq = lane >> 4;
            for (int rbk = gw; rbk < MTOK / 16; rbk += NGW) {
                const bf16_t* ap = HG + (size_t)(rbk * 16 + fr) * DM + 8 * fq; const bf16_t* bp = WgT + (size_t)fr * DM + 8 * fq;
                f32x4 acc = (f32x4){0.f, 0.f, 0.f, 0.f};
#pragma unroll 8
                for (int ks = 0; ks < 32; ++ks) acc = __builtin_amdgcn_mfma_f32_16x16x32_bf16(*(const bf16x8*)(ap + 32 * ks), *(const bf16x8*)(bp + 32 * ks), acc, 0, 0, 0);
                const float bias = bg[fr];
#pragma unroll
                for (int j = 0; j < 4; ++j) { const int row = rbk * 16 + 4 * fq + j; const float rs = 1.0f / __builtin_sqrtf(ssq1[row] * (1.0f / DM) + EPS); GATES[(size_t)row * 16 + fr] = acc[j] * rs + bias; }
            }
        }
        pg8::Gemm g{HG, (const bf16_t*)(ws + WS_WIN), MTOK, 3072, DM}; pg8::StaticOrder S; S.init(MTOK, 3072, G, bx);
        pg8::EpiZ E{ZB, KTG, VTG, ssq + MTOK};
        pg8::gemm_phase<pg8::EpiZ, pg8::StaticOrder, true, true>(lds, g, S, E);
    }
    SEAM(3);
    if (IN(4)) for (int rep = 0; rep < REPS(4); ++rep) {
        if (rep) xcd_barrier(bar);
        volatile LAS unsigned* cw = (volatile LAS unsigned*)(lds + LDS_CTLW);
        for (int ch = bx; ch < 128; ch += G) mls::chain(lds, ZB, GATES, args.in[8], HBUF, ch);
        const float d1 = wave_sum(args.in[10][lane] * args.in[11][lane]), d2 = wave_sum(args.in[12][lane] * args.in[13][lane]);
        const float lam_init = 0.2f; const float lam = expf(d1) - expf(d2) + lam_init;
        const int q0 = (int)(xb_xcc_id() & 7u);
        for (int qi = 0; qi < 8; ++qi) {
            const int qq = (q0 + qi) & 7;
            for (;;) {
                if (tid == 0) cw[0] = atomicAdd(ctl + 64 * (1 + qq) + 16 * rep, 1u);
                __syncthreads();
                const unsigned li = cw[0];
                __syncthreads();
                if (li >= 128u) break;
                att::attn_unit(lds, ZB, KTG, VTG, MIX, args.in[14], 128 * qq + (int)li, lam, 1.0f - lam_init);
            }
        }
        if (rep == 0) for (;;) {
            if (tid == 0) cw[0] = atomicAdd(ctl + 640, 8u);
            __syncthreads();
            const unsigned base = cw[0];
            __syncthreads();
            if (base >= (unsigned)LATE_N) break;
            if ((int)base + wave < LATE_N) late_item(args, (LAS float*)(lds + wave * 16384), lane, (int)base + wave);
        }
    }
    SEAM(4);
    if (IN(5)) {
        const float* gm = args.in[9];
        f32x4 g0 = *(const f32x4*)(gm + 8 * lane), g1 = *(const f32x4*)(gm + 8 * lane + 4);
        for (int row = gw; row < MTOK; row += NGW) {
            const u32x4 a = *(const u32x4*)(HBUF + (size_t)row * 512 + 8 * lane), bq = *(const u32x4*)(HBUF + ((size_t)MTOK + row) * 512 + 8 * lane);
            const u32x4 o = *(const u32x4*)(ZB + (size_t)row * ZLD + 1024 + 8 * lane);
            float v[8]; float s = 0.f;
#pragma unroll
            for (int e = 0; e < 4; ++e) { v[2 * e] = bf_lo(a[e]) + bf_lo(bq[e]); v[2 * e + 1] = bf_hi(a[e]) + bf_hi(bq[e]); s += v[2 * e] * v[2 * e] + v[2 * e + 1] * v[2 * e + 1]; }
            s += __shfl_xor(s, 1); s += __shfl_xor(s, 2); s += __shfl_xor(s, 4); s += __shfl_xor(s, 8);
            const float rn = 1.0f / __builtin_sqrtf(s * (1.0f / 128.0f) + EPS);
            float y[8]; const float gg[8] = {g0[0], g0[1], g0[2], g0[3], g1[0], g1[1], g1[2], g1[3]};
#pragma unroll
            for (int e = 0; e < 4; ++e) { y[2 * e] = pg8::sigmoid_f(bf_lo(o[e])) * v[2 * e] * rn * gg[2 * e]; y[2 * e + 1] = pg8::sigmoid_f(bf_hi(o[e])) * v[2 * e + 1] * rn * gg[2 * e + 1]; }
            u32x4 w; w.x = cvt_pk_bf16(y[0], y[1]); w.y = cvt_pk_bf16(y[2], y[3]); w.z = cvt_pk_bf16(y[4], y[5]); w.w = cvt_pk_bf16(y[6], y[7]);
            *(u32x4*)(MIX + (size_t)row * DM + 8 * lane) = w;
        }
    }
    SEAM(5);
    if (IN(6)) {
        pg8::Gemm g{MIX, (const bf16_t*)(ws + WS_WOUT), MTOK, DM, DM}; pg8::StaticOrder S; S.init(MTOK, DM, G, bx);
        pg8::EpiRes<0> E{out, out, 1.0f, HG, args.in[16], ssq + 2 * MTOK, nullptr};
        pg8::gemm_phase<pg8::EpiRes<0>, pg8::StaticOrder, true, true>(lds, g, S, E);
    }
    SEAM(6);
    if (IN(7)) {
        pg8::Gemm g{HG, (const bf16_t*)(ws + WS_W1B), MTOK, 2 * DFF, DM}; pg8::StaticOrder S; S.init(MTOK, 2 * DFF, G, bx);
        pg8::EpiAct<0> E{ACT, DFF, ssq + 2 * MTOK};
        pg8::gemm_phase<pg8::EpiAct<0>, pg8::StaticOrder, true, true>(lds, g, S, E);
    }
    SEAM(7);
    if (IN(8)) {
        pg8::Gemm g{ACT, (const bf16_t*)(ws + WS_W2B), MTOK, DM, DFF}; pg8::StaticOrder S; S.init(MTOK, DM, G, bx);
        pg8::EpiRes<0> E{out, out, 0.5f, HG, args.in[19], ssq + 3 * MTOK, nullptr};
        pg8::gemm_phase<pg8::EpiRes<0>, pg8::StaticOrder, true, true>(lds, g, S, E);
    }
    SEAM(8);
    if (IN(9)) for (int rep = 0; rep < REPS(9); ++rep) {   if (rep) xcd_barrier(bar);
        pg8::Gemm g{HG, (const bf16_t*)(ws + WS_WG), MTOK, DM, DM}; pg8::StaticOrder S; S.init(MTOK, DM, G, bx);
        pg8::EpiAct<1> E{MIX, DM, ssq + 3 * MTOK};
        pg8::gemm_phase<pg8::EpiAct<1>, pg8::StaticOrder, true, true>(lds, g, S, E);
    }
    if (IN(10)) {
        int kple = PLE; asm volatile("" : "+s"(kple));
        pg8::Gemm g{PB, (const bf16_t*)(ws + WS_WP), MTOK, DM, kple}; pg8::StaticOrder S; S.init(MTOK, DM, G, bx);
        pg8::EpiRes<1> E{out, out, 1.0f, nullptr, nullptr, ssq + 4 * MTOK, MIX};
        pg8::gemm_phase<pg8::EpiRes<1>, pg8::StaticOrder, true, true>(lds, g, S, E);
    }
    SEAM(10);
    if (IN(11)) {
        const float* gf = args.in[22];
        f32x4 gv[4];
#pragma unroll
        for (int j = 0; j < 4; ++j) gv[j] = *((const f32x4*)gf + lane + 64 * j);
        for (int row = gw; row < MTOK; row += NGW) {
            f32x4* xr = (f32x4*)(out + (size_t)row * DM) + lane; f32x4 v[4]; float s = 0.f;
#pragma unroll
            for (int j = 0; j < 4; ++j) { v[j] = xr[64 * j]; s += (v[j][0] * v[j][0] + v[j][1] * v[j][1]) + (v[j][2] * v[j][2] + v[j][3] * v[j][3]); }
            s = wave_sum(s);
            const float rs = 1.0f / __builtin_sqrtf(s * (1.0f / DM) + EPS);
#pragma unroll
            for (int j = 0; j < 4; ++j) xr[64 * j] = v[j] * rs * gv[j];
        }
    }
#undef IN
#undef SEAM
}

#ifndef MK_SPLIT
#define MK_SPLIT 0
#endif
extern "C" void kernel_launch(void* const* d_in, const int* in_sizes, int n_in, void* d_out, int out_size, void* d_ws, size_t ws_size, hipStream_t stream) {
    static int grid = 0;
    if (grid == 0) {
        if (n_in != 23 || in_sizes[0] != MTOK * DM || out_size != MTOK * DM || ws_size < WS_END) {
            fprintf(stderr, "kernel_launch: unexpected shapes (n_in %d, in0 %d, out %d, ws %zu); nothing launched\n", n_in, n_in > 0 ? in_sizes[0] : -1, out_size, ws_size); grid = -1; return; }
        int dev = 0, cus = 0, per_cu = 0;
        hipGetDevice(&dev); hipDeviceGetAttribute(&cus, hipDeviceAttributeMultiprocessorCount, dev);
        hipFuncSetAttribute((const void*)fwd_megakernel, hipFuncAttributeMaxDynamicSharedMemorySize, LDS_BYTES);
        hipOccupancyMaxActiveBlocksPerMultiprocessor(&per_cu, (const void*)fwd_megakernel, 512, LDS_BYTES);
        (void)hipGetLastError();
        if (per_cu < 1) fprintf(stderr, "kernel_launch: occupancy query says %d blocks/CU\n", per_cu);
        grid = cus > 0 ? cus : 256;
    }
    if (grid < 0) return;
    hipMemsetAsync((char*)d_ws + WS_CTL, 0, CTL_ZERO_BYTES, stream);
    Args a{};
    for (int i = 0; i < 23; ++i) a.in[i] = (const float*)d_in[i];
    a.out = (float*)d_out; a.ws = (unsigned char*)d_ws;
#if MK_SPLIT
    for (int ph = 0; ph < NPH; ++ph) { a.ph_lo = ph; a.ph_hi = ph + 1; hipLaunchKernelGGL(fwd_megakernel, dim3(grid), dim3(512), LDS_BYTES, stream, a); }
#else
    a.ph_lo = 0; a.ph_hi = NPH;
    void* kargs[] = {&a};
    hipError_t e = hipLaunchCooperativeKernel((const void*)fwd_megakernel, dim3(grid), dim3(512), kargs, LDS_BYTES, stream);
    if (e != hipSuccess) fprintf(stderr, "cooperative launch failed: %s (grid %d)\n", hipGetErrorString(e), grid);
#endif
}
```
